# Optimizing an MI355X kernel written in HIP

```python
import jax, jax.numpy as jnp
from jax import lax
import numpy as np

D_MODEL = 1024
BATCH = 32
SEQ = 2048
DEPTH = 4
DEC_BATCH = 8
DEC_SEQ = 32
PAST_LEN = 1024

CHUNK = 64
HEAD_DIM = 64
MIX_W = D_MODEL
MIX_HEADS = MIX_W // HEAD_DIM
N_MEM = 256
N_HEADS_MEM = 4
N_HEADS_A = MIX_HEADS - N_HEADS_MEM
N_HEADS_B = MIX_HEADS - N_HEADS_MEM
N_A_LAYERS = DEPTH // 2
N_B_LAYERS = DEPTH - N_A_LAYERS
BAND_CHUNKS = 8
WINDOW_B = BAND_CHUNKS * CHUNK
BAND = (BAND_CHUNKS + 1) * CHUNK
REL_CLIP = 128
SB_BLOCK = 128
D_FF = ((8 * D_MODEL // 3 + 255) // 256) * 256
EPS = 1e-6
NEG = -1e30

kernel_name = 'yoco_stickbreak_chunkband_streaming_encoder'


def rmsnorm(x, g):
    xf = x.astype(jnp.float32)
    y = xf * lax.rsqrt(jnp.mean(xf * xf, axis=-1, keepdims=True) + EPS)
    return (y * g.astype(jnp.float32)).astype(x.dtype)


def swiglu(x, w_gu, w_down):
    gate, up = jnp.split(x @ w_gu, 2, axis=-1)
    return (jax.nn.silu(gate) * up) @ w_down


def heads(t, n):
    return t.reshape(t.shape[:-1] + (n, HEAD_DIM))


def _sb_block(q, k, v, q_pos, k_pos):
    z = jnp.einsum('bqhd,bkhd->bhqk', q, k, preferred_element_type=jnp.float32) * (HEAD_DIM ** -0.5)
    vis = k_pos[None, :] < q_pos[:, None]
    log_keep = jnp.where(vis, jax.nn.log_sigmoid(-z), 0.0)
    after = lax.cumsum(log_keep, axis=log_keep.ndim - 1, reverse=True) - log_keep
    w = jnp.where(vis, jnp.exp(jax.nn.log_sigmoid(z) + after), 0.0)
    return jnp.einsum('bhqk,bkhd->bqhd', w.astype(v.dtype), v)


def stick_breaking(q, k, v, q_start):
    b, tq, h, d = q.shape
    blk = min(SB_BLOCK, tq)
    nb = tq // blk
    k_pos = jnp.arange(k.shape[1])
    qb = q.reshape(b, nb, blk, h, d).swapaxes(0, 1)

    def body(args):
        qi, i = args
        q_pos = q_start + i * blk + jnp.arange(blk)
        return _sb_block(qi, k, v, q_pos, k_pos)

    out = lax.map(body, (qb, jnp.arange(nb)))
    return out.swapaxes(0, 1).reshape(b, tq, h, d)


def _band_block(q, k, v, q_pos, k_pos, bias):
    s = jnp.einsum('bqhd,bkhd->bhqk', q, k, preferred_element_type=jnp.float32) * (HEAD_DIM ** -0.5)
    rel = jnp.clip(q_pos[:, None] - k_pos[None, :], -REL_CLIP, REL_CLIP) + REL_CLIP
    s = s + bias.astype(jnp.float32)[:, rel][None]
    qc = q_pos[:, None] // CHUNK
    kc = k_pos[None, :] // CHUNK
    vis = (k_pos[None, :] >= 0) & (kc <= qc) & (kc >= qc - BAND_CHUNKS)
    p = jax.nn.softmax(jnp.where(vis[None, None], s, NEG), axis=-1)
    return jnp.einsum('bhqk,bkhd->bqhd', p.astype(v.dtype), v)


def chunk_band_prompt(q, k, v, bias):
    b, t, h, d = q.shape
    nc = t // CHUNK
    pad = ((0, 0), (WINDOW_B, 0), (0, 0), (0, 0))
    kp = jnp.pad(k, pad)
    vp = jnp.pad(v, pad)
    qc = q.reshape(b, nc, CHUNK, h, d).swapaxes(0, 1)

    def body(args):
        qi, c = args
        start = c * CHUNK
        kb = lax.dynamic_slice_in_dim(kp, start, BAND, axis=1)
        vb = lax.dynamic_slice_in_dim(vp, start, BAND, axis=1)
        q_pos = start + jnp.arange(CHUNK)
        k_pos = start - WINDOW_B + jnp.arange(BAND)
        return _band_block(qi, kb, vb, q_pos, k_pos, bias)

    out = lax.map(body, (qc, jnp.arange(nc)))
    return out.swapaxes(0, 1).reshape(b, t, h, d)


def chunk_band_step(q, k_all, v_all, q_start, bias):
    tq = q.shape[1]
    tk = k_all.shape[1]
    q_pos = q_start + jnp.arange(tq)
    k_pos = q_start + tq - tk + jnp.arange(tk)
    return _band_block(q, k_all, v_all, q_pos, k_pos, bias)


def mem_attend(q, mk, mv):
    s = jnp.einsum('bqhd,bmhd->bhqm', q, mk, preferred_element_type=jnp.float32) * (HEAD_DIM ** -0.5)
    p = jax.nn.softmax(s, axis=-1)
    return jnp.einsum('bhqm,bmhd->bqhd', p.astype(mv.dtype), mv)


def setup_inputs(seed: int = 0) -> dict:
    key = jax.random.key(seed)
    ks = jax.random.split(key, 32)
    f32 = jnp.float32
    a_w = N_HEADS_A * HEAD_DIM
    b_w = N_HEADS_B * HEAD_DIM
    m_w = N_HEADS_MEM * HEAD_DIM
    wc = min(WINDOW_B, PAST_LEN)

    def nrm(k, shape, scale=1.0):
        return jax.random.normal(k, shape, f32) * scale

    def gain(k, shape):
        return 1.0 + 0.05 * jax.random.normal(k, shape, f32)

    dsc = D_MODEL ** -0.5
    return {
        'x_prompt': nrm(ks[0], (BATCH, SEQ, D_MODEL)),
        'x_sample': nrm(ks[1], (DEC_BATCH, DEC_SEQ, D_MODEL)),
        'cache_a_k': nrm(ks[2], (N_A_LAYERS, DEC_BATCH, PAST_LEN, N_HEADS_A, HEAD_DIM)),
        'cache_a_v': nrm(ks[3], (N_A_LAYERS, DEC_BATCH, PAST_LEN, N_HEADS_A, HEAD_DIM)),
        'cache_b_k': nrm(ks[4], (DEC_BATCH, wc, N_HEADS_B, HEAD_DIM)),
        'cache_b_v': nrm(ks[5], (DEC_BATCH, wc, N_HEADS_B, HEAD_DIM)),
        'cache_mem_k': nrm(ks[6], (DEPTH, DEC_BATCH, N_MEM, N_HEADS_MEM, HEAD_DIM)),
        'cache_mem_v': nrm(ks[7], (DEPTH, DEC_BATCH, N_MEM, N_HEADS_MEM, HEAD_DIM)),
        'mem_prompt': nrm(ks[8], (BATCH, N_MEM, D_MODEL)),
        'g_ff1': gain(ks[9], (DEPTH, D_MODEL)),
        'w_ff1_gu': nrm(ks[10], (DEPTH, D_MODEL, 2 * D_FF), dsc),
        'w_ff1_down': nrm(ks[11], (DEPTH, D_FF, D_MODEL), D_FF ** -0.5),
        'g_mix': gain(ks[12], (DEPTH, D_MODEL)),
        'w_in_a': nrm(ks[13], (N_A_LAYERS, D_MODEL, 3 * a_w + m_w), dsc),
        'w_in_b': nrm(ks[14], (N_B_LAYERS, D_MODEL, b_w + m_w), dsc),
        'w_out': nrm(ks[15], (DEPTH, MIX_W, D_MODEL), MIX_W ** -0.5),
        'g_mem': gain(ks[16], (DEPTH, D_MODEL)),
        'w_mem_kv': nrm(ks[17], (DEPTH, D_MODEL, 2 * m_w), dsc),
        'g_kv': gain(ks[18], (D_MODEL,)),
        'w_kv_b': nrm(ks[19], (D_MODEL, 2 * b_w), dsc),
        'rel_bias_b': nrm(ks[20], (N_B_LAYERS, N_HEADS_B, 2 * REL_CLIP + 1), 0.1),
        'g_ff2': gain(ks[21], (DEPTH, D_MODEL)),
        'w_ff2_gu': nrm(ks[22], (DEPTH, D_MODEL, 2 * D_FF), dsc),
        'w_ff2_down': nrm(ks[23], (DEPTH, D_FF, D_MODEL), D_FF ** -0.5),
        'g_final': gain(ks[24], (D_MODEL,)),
    }


def reference(x_prompt, x_sample, cache_a_k, cache_a_v, cache_b_k, cache_b_v, cache_mem_k, cache_mem_v,
              mem_prompt, g_ff1, w_ff1_gu, w_ff1_down, g_mix, w_in_a, w_in_b, w_out, g_mem, w_mem_kv,
              g_kv, w_kv_b, rel_bias_b, g_ff2, w_ff2_gu, w_ff2_down, g_final):
    a_w = N_HEADS_A * HEAD_DIM
    b_w = N_HEADS_B * HEAD_DIM
    m_w = N_HEADS_MEM * HEAD_DIM

    def run(x, mem_k, mem_v, past_a_k, past_a_v, past_b_k, past_b_v):
        bn, t, _ = x.shape
        has_past = past_a_k is not None
        q_start = past_a_k.shape[2] if has_past else 0
        a_k_rows, a_v_rows = [], []
        kb = vb = kb_all = vb_all = None
        for l in range(DEPTH):
            x = x + 0.5 * swiglu(rmsnorm(x, g_ff1[l]), w_ff1_gu[l], w_ff1_down[l])
            h = rmsnorm(x, g_mix[l])
            if l < N_A_LAYERS:
                proj = h @ w_in_a[l]
                q = heads(proj[..., :a_w], N_HEADS_A)
                k = heads(proj[..., a_w:2 * a_w], N_HEADS_A)
                v = heads(proj[..., 2 * a_w:3 * a_w], N_HEADS_A)
                qm = heads(proj[..., 3 * a_w:], N_HEADS_MEM)
                a_k_rows.append(k)
                a_v_rows.append(v)
                if has_past:
                    k = jnp.concatenate([past_a_k[l], k], axis=1)
                    v = jnp.concatenate([past_a_v[l], v], axis=1)
                o_tok = stick_breaking(q, k, v, q_start)
            else:
                j = l - N_A_LAYERS
                proj = h @ w_in_b[j]
                q = heads(proj[..., :b_w], N_HEADS_B)
                qm = heads(proj[..., b_w:], N_HEADS_MEM)
                if has_past:
                    o_tok = chunk_band_step(q, kb_all, vb_all, q_start, rel_bias_b[j])
                else:
                    o_tok = chunk_band_prompt(q, kb, vb, rel_bias_b[j])
            o_mem = mem_attend(qm, mem_k[l], mem_v[l])
            o = jnp.concatenate([o_tok.reshape(bn, t, -1), o_mem.reshape(bn, t, -1)], axis=-1)
            x = x + o @ w_out[l]
            x = x + 0.5 * swiglu(rmsnorm(x, g_ff2[l]), w_ff2_gu[l], w_ff2_down[l])
            if l == N_A_LAYERS - 1:
                kv = rmsnorm(x, g_kv) @ w_kv_b
                kb = heads(kv[..., :b_w], N_HEADS_B)
                vb = heads(kv[..., b_w:], N_HEADS_B)
                if has_past:
                    kb_all = jnp.concatenate([past_b_k, kb], axis=1)
                    vb_all = jnp.concatenate([past_b_v, vb], axis=1)
        return rmsnorm(x, g_final), jnp.stack(a_k_rows), jnp.stack(a_v_rows), kb, vb

    mk_list, mv_list = [], []
    for l in range(DEPTH):
        mkv = rmsnorm(mem_prompt, g_mem[l]) @ w_mem_kv[l]
        mk_list.append(heads(mkv[..., :m_w], N_HEADS_MEM))
        mv_list.append(heads(mkv[..., m_w:], N_HEADS_MEM))
    mem_k_prompt = jnp.stack(mk_list)
    mem_v_prompt = jnp.stack(mv_list)

    y_prompt, a_k_prompt, a_v_prompt, kb_p, vb_p = run(
        x_prompt, mem_k_prompt, mem_v_prompt, None, None, None, None)
    keep = min(WINDOW_B, kb_p.shape[1])
    b_k_prompt = kb_p[:, kb_p.shape[1] - keep:]
    b_v_prompt = vb_p[:, vb_p.shape[1] - keep:]

    y_sample, a_k_sample, a_v_sample, b_k_sample, b_v_sample = run(
        x_sample, cache_mem_k, cache_mem_v, cache_a_k, cache_a_v, cache_b_k, cache_b_v)

    return (y_prompt, y_sample, a_k_prompt, a_v_prompt, b_k_prompt, b_v_prompt, mem_k_prompt, mem_v_prompt,
            a_k_sample, a_v_sample, b_k_sample, b_v_sample)
```

```cpp
#include <hip/hip_runtime.h>
#include <hip/hip_cooperative_groups.h>
#include <cstdio>
#include <cstdint>
namespace cg = cooperative_groups;
namespace pg8 {
#define PG8_LAS __attribute__((address_space(3)))
typedef unsigned short bf16_t;
typedef short bf16x8 __attribute__((ext_vector_type(8)));
typedef float f32x4 __attribute__((ext_vector_type(4)));
typedef unsigned u32x4 __attribute__((ext_vector_type(4)));
constexpr int BM = 256, BK = 64, HALF = 128, HTB = HALF * BK * 2  , STAGE_BYTES = 8 * HTB, NXCD = 8, WGM = 8;

__host__ __device__ __forceinline__ int lds_byte(int r, int c) { const int st = (r >> 4) * 2 + (c >> 5), rr = r & 15, cc = c & 31, ob = rr * 64 + cc * 2; return st * 1024 + (ob ^ (((ob >> 9) & 1) << 5)); }
__host__ __device__ __forceinline__ void stage_rc(int b, int& R, int& C) { const int st = b / 1024, sb = b % 1024, swz = sb ^ (((sb >> 9) & 1) << 5); R = (st >> 1) * 16 + swz / 64; C = (st & 1) * 32 + (swz % 64) / 2; }
__host__ __device__ __forceinline__ int perm32(int rho) { const int n = rho >> 4, i = rho & 15; return 8 * (i >> 2) + 4 * n + (i & 3); }

struct Unit { int pm, pn; };
struct Gemm { const bf16_t* A; const bf16_t* Bt; int M, N, K; };

struct StaticOrder {
    int nM, nN, nwg, G, c;
    __host__ __device__ void init(int M, int N, int G_, int c_) { nM = M / BM; nN = N / BM; nwg = nM * nN; G = G_; c = c_; }
    __host__ __device__ bool next(int i, Unit& u) const {
        const long L = (long)i * G + c; if (L >= nwg) return false;
        int wgid = (int)L; { const int q = nwg / NXCD, r = nwg % NXCD, xcd = wgid % NXCD, off = wgid / NXCD; wgid = (xcd < r ? xcd * (q + 1) : r * (q + 1) + (xcd - r) * q) + off; }
        const int nig = WGM * nN, gid = wgid / nig, fm = gid * WGM, gsz = (nM - fm) < WGM ? (nM - fm) : WGM;
        u.pm = fm + ((wgid % nig) % gsz); u.pn = (wgid % nig) / gsz; return true;
    }
    __device__ __forceinline__ void a_ready(const Unit&) const {}
    __device__ __forceinline__ void done(const Unit&) const {}
};

__device__ __forceinline__ unsigned cvt_pk_bf16(float lo, float hi) { unsigned r; asm volatile("v_cvt_pk_bf16_f32 %0, %1, %2" : "=v"(r) : "v"(lo), "v"(hi)); return r; }

__device__ __forceinline__ u32x4 pack8(const f32x4& a, const f32x4& b) { u32x4 w; w.x = cvt_pk_bf16(a[0], a[1]); w.y = cvt_pk_bf16(a[2], a[3]); w.z = cvt_pk_bf16(b[0], b[1]); w.w = cvt_pk_bf16(b[2], b[3]); return w; }

struct EpiGU {
    static constexpr bool PERM = true, AFTER_DRAIN = false;
    bf16_t* H; const float* ss;
    __device__ __forceinline__ void operator()(const f32x4 (&acc)[2][2][4][2], const Unit& u, int wr, int wc, int fr_, int fq_) const {
        int fr = fr_, fq = fq_; asm volatile("" : "+v"(fr), "+v"(fq));
        bf16_t* Hu = H + (size_t)u.pm * BM * 2816 + u.pn * 128; const float* ssu = ss + u.pm * BM;
        const unsigned rl0 = wr * 64 + fr, cl0 = wc * 32 + 8 * fq;
        float rsv[2][4];
#pragma unroll
        for (int ai = 0; ai < 2; ++ai)
#pragma unroll
            for (int m = 0; m < 4; ++m) rsv[ai][m] = ssu[rl0 + ai * HALF + m * 16];
#pragma unroll
        for (int ai = 0; ai < 2; ++ai)
#pragma unroll
            for (int m = 0; m < 4; ++m) {
                const unsigned rl = rl0 + ai * HALF + m * 16;
                const float rs = __builtin_amdgcn_rsqf(rsv[ai][m] * (1.0f / 1024.0f) + 1e-6f);
                f32x4 h[2]; const float k1 = rs * -1.4426950408889634f, rs2 = rs * rs;
#pragma unroll
                for (int n = 0; n < 2; ++n) {
                    const f32x4 t = acc[ai][0][m][n] * k1, gu = acc[ai][0][m][n] * acc[ai][1][m][n];
                    f32x4 e;
#pragma unroll
                    for (int j = 0; j < 4; ++j) e[j] = __builtin_amdgcn_exp2f(t[j]);
                    e = e + 1.0f;
#pragma unroll
                    for (int j = 0; j < 4; ++j) e[j] = __builtin_amdgcn_rcpf(e[j]);
                    h[n] = gu * (e * rs2);
                }
                *(u32x4*)(Hu + (rl * 2816u + cl0)) = pack8(h[0], h[1]);
            }
    }
};

__device__ __forceinline__ f32x4 unpk_lo(const u32x4& w) { f32x4 r; r[0] = __builtin_bit_cast(float, w.x << 16); r[1] = __builtin_bit_cast(float, w.x & 0xffff0000u); r[2] = __builtin_bit_cast(float, w.y << 16); r[3] = __builtin_bit_cast(float, w.y & 0xffff0000u); return r; }
__device__ __forceinline__ f32x4 unpk_hi(const u32x4& w) { f32x4 r; r[0] = __builtin_bit_cast(float, w.z << 16); r[1] = __builtin_bit_cast(float, w.z & 0xffff0000u); r[2] = __builtin_bit_cast(float, w.w << 16); r[3] = __builtin_bit_cast(float, w.w & 0xffff0000u); return r; }
struct EpiRes {
    static constexpr bool PERM = true, AFTER_DRAIN = false;
    bf16_t* XB; float* ssn; float sc;
    __device__ __forceinline__ void operator()(const f32x4 (&acc)[2][2][4][2], const Unit& u, int wr, int wc, int fr_, int fq_) const {
        int fr = fr_, fq = fq_; asm volatile("" : "+v"(fr), "+v"(fq));
        bf16_t* XBu = XB + (size_t)u.pm * BM * 1024 + u.pn * BM; float* ssu = ssn + u.pm * BM;
        const unsigned rl0 = wr * 64 + fr, cl0 = wc * 32 + 8 * fq;
        u32x4 xin[2][4][2];
#pragma unroll
        for (int ai = 0; ai < 2; ++ai)
#pragma unroll
            for (int m = 0; m < 4; ++m)
#pragma unroll
                for (int bj = 0; bj < 2; ++bj) xin[ai][m][bj] = *(const u32x4*)(XBu + ((rl0 + ai * HALF + m * 16) * 1024u + cl0 + bj * HALF));
#pragma unroll
        for (int ai = 0; ai < 2; ++ai)
#pragma unroll
            for (int m = 0; m < 4; ++m) {
                const unsigned rl = rl0 + ai * HALF + m * 16;
                float part = 0.f;
#pragma unroll
                for (int bj = 0; bj < 2; ++bj) {
                    const unsigned off = rl * 1024u + cl0 + bj * HALF;
                    const u32x4 w = xin[ai][m][bj];
                    f32x4 x0 = unpk_lo(w), x1 = unpk_hi(w);
                    x0 = x0 + acc[ai][bj][m][0] * sc; x1 = x1 + acc[ai][bj][m][1] * sc;
                    *(u32x4*)(XBu + off) = pack8(x0, x1);
                    part += (x0[0] * x0[0] + x0[1] * x0[1]) + (x0[2] * x0[2] + x0[3] * x0[3]) + (x1[0] * x1[0] + x1[1] * x1[1]) + (x1[2] * x1[2] + x1[3] * x1[3]);
                }
                part += __shfl_xor(part, 16); part += __shfl_xor(part, 32);
                if (fq == 0) unsafeAtomicAdd(ssu + rl, part);
            }
    }
};

struct Route { bf16_t* b; float* f; int ldb, ldf, grp; };
struct ProjCtx {
    int kind, l;
    bf16_t *QO, *Kp, *Vp, *Ks, *Vs, *KBp, *VBp, *KBs, *VBs, *MKV;
    float* out;
};
constexpr size_t O_YS = 67108864, O_AKP = 67371008, O_AVP = 168034304, O_BKP = 268697600, O_BVP = 281280512, O_MKP = 293863424, O_MVP = 302252032,
                 O_AKS = 310640640, O_AVS = 311033856, O_BKS = 311427072, O_BVS = 311623680, O_END = 311820288;
__device__ __forceinline__ Route route_unit(const ProjCtx& c, const Unit& u) {
    Route r; r.b = nullptr; r.f = nullptr; r.ldb = 1024; r.ldf = 768; r.grp = 0;
    const int pm = u.pm, pn = u.pn; const bool smp = (pm == 256);
    if (c.kind == 0) {
        if (pn < 3 || pn == 9) { r.b = c.QO + (size_t)pm * 256 * 1024 + (pn == 9 ? 768 : pn * 256); r.ldb = 1024; }
        else { const bool isv = pn >= 6; const int ck = (pn - (isv ? 6 : 3)) * 256; r.ldb = 768; r.ldf = 768;
            if (!smp) { r.b = (isv ? c.Vp : c.Kp) + (size_t)pm * 256 * 768 + ck; r.f = c.out + (isv ? O_AVP : O_AKP) + ((size_t)c.l * 65536 + (size_t)pm * 256) * 768 + ck; }
            else { r.b = (isv ? c.Vs : c.Ks) + (size_t)1024 * 768 + ck; r.grp = 1056; r.f = c.out + (isv ? O_AVS : O_AKS) + (size_t)c.l * 256 * 768 + ck; } }
    } else if (c.kind == 1) {
        r.b = c.QO + (size_t)pm * 256 * 1024 + pn * 256; r.ldb = 1024;
    } else if (c.kind == 2) {
        const bool isv = pn >= 3; const int ck = (pn - (isv ? 3 : 0)) * 256; r.ldb = 768; r.ldf = 768;
        if (!smp) { r.b = (isv ? c.VBp : c.KBp) + (size_t)pm * 256 * 768 + ck;
            if ((pm & 7) >= 6) r.f = c.out + (isv ? O_BVP : O_BKP) + ((size_t)(pm >> 3) * 512 + (size_t)((pm & 7) - 6) * 256) * 768 + ck; }
        else { r.b = (isv ? c.VBs : c.KBs) + (size_t)512 * 768 + ck; r.grp = 544; r.f = c.out + (isv ? O_BVS : O_BKS) + ck; }
    } else {
        const int l = pn >> 1, kv = pn & 1;
        r.b = c.MKV + (size_t)pm * 256 * 2048 + pn * 256; r.ldb = 2048;
        r.f = c.out + (kv ? O_MVP : O_MKP) + ((size_t)(l * 32 + pm) * 256) * 256; r.ldf = 256;
    }
    return r;
}
struct EpiProj {
    static constexpr bool PERM = true, AFTER_DRAIN = false;
    const float* ss; ProjCtx c;
    __device__ __forceinline__ void operator()(const f32x4 (&acc)[2][2][4][2], const Unit& u, int wr, int wc, int fr_, int fq_) const {
        int fr = fr_, fq = fq_; asm volatile("" : "+v"(fr), "+v"(fq));
        const Route rt = route_unit(c, u);
        const unsigned rl0 = wr * 64 + fr, cl0 = wc * 32 + 8 * fq; const float* ssu = ss + u.pm * BM;
        float rsv[2][4];
#pragma unroll
        for (int ai = 0; ai < 2; ++ai)
#pragma unroll
            for (int m = 0; m < 4; ++m) rsv[ai][m] = ssu[rl0 + ai * HALF + m * 16];
#pragma unroll
        for (int ai = 0; ai < 2; ++ai)
#pragma unroll
            for (int m = 0; m < 4; ++m) {
                const unsigned rl = rl0 + ai * HALF + m * 16;
                const float rs = __builtin_amdgcn_rsqf(rsv[ai][m] * (1.0f / 1024.0f) + 1e-6f);
                const unsigned rb = rt.grp ? (rl >> 5) * (unsigned)rt.grp + (rl & 31u) : rl;
#pragma unroll
                for (int bj = 0; bj < 2; ++bj) {
                    const f32x4 v0 = acc[ai][bj][m][0] * rs, v1 = acc[ai][bj][m][1] * rs; const unsigned cl = cl0 + bj * HALF;
                    if (rt.b) *(u32x4*)(rt.b + (rb * (unsigned)rt.ldb + cl)) = pack8(v0, v1);
                    if (rt.f) { float* fp = rt.f + (rl * (unsigned)rt.ldf + cl); *(f32x4*)fp = v0; *(f32x4*)(fp + 4) = v1; }
                }
            }
    }
};

template <class Epi, class Sched, bool ALIGN_EPI = false, bool SP2 = false>
__device__ __forceinline__ void gemm_phase(PG8_LAS unsigned char* lds, const Gemm g, const Sched& S, const Epi& E) {
    int tid_ = threadIdx.x; asm volatile("" : "+v"(tid_));
    const int tid = tid_, wid = __builtin_amdgcn_readfirstlane(tid >> 6), lane = tid & 63, wr = wid >> 2, wc = wid & 3, fr = lane & 15, fq = lane >> 4;
    const int K = g.K, nt = K / BK;
    unsigned voffA[2], voffB[2];
#pragma unroll
    for (int i = 0; i < 2; ++i) { int R, C; stage_rc(tid * 16 + i * 8192, R, C); const int Rb = Epi::PERM ? ((R & ~31) + perm32(R & 31)) : R;
        voffA[i] = (unsigned)(R * K + C) * 2u; voffB[i] = (unsigned)(Rb * K + C) * 2u; }
    const size_t kstep = (size_t)(BK * 2);
    const size_t hstep = (size_t)HALF * K * 2;
    const size_t tstep = 2 * hstep;
    const unsigned ldsw = (unsigned)wid * 1024u;
    const int aoff = lds_byte(wr * 64 + fr, fq * 8), boff = lds_byte(wc * 32 + fr, fq * 8);
#define PG8_SA(b, h) (((b) * 2 + (h)) * HTB)
#define PG8_SB(b, h) ((4 + (b) * 2 + (h)) * HTB)
#define PG8_STAGE(bufoff, gbase, voff) do { _Pragma("unroll") for (int _i = 0; _i < 2; ++_i) \
        __builtin_amdgcn_global_load_lds((const unsigned*)((const char*)(gbase) + (voff)[_i]), (PG8_LAS unsigned*)(lds + (bufoff) + ldsw + _i * 8192), 16, 0, 0); } while (0)
#define PG8_LDA(dst, b, h) do { _Pragma("unroll") for (int m = 0; m < 4; ++m) _Pragma("unroll") for (int k = 0; k < 2; ++k) dst[m][k] = *(const PG8_LAS bf16x8*)(lds + PG8_SA(b, h) + aoff + m * 2048 + k * 1024); } while (0)
#define PG8_LDB(dst, b, h) do { _Pragma("unroll") for (int n = 0; n < 2; ++n) _Pragma("unroll") for (int k = 0; k < 2; ++k) dst[n][k] = *(const PG8_LAS bf16x8*)(lds + PG8_SB(b, h) + boff + n * 2048 + k * 1024); } while (0)
#define PG8_MMA(ai, bj, At, Bt) do { __builtin_amdgcn_s_setprio(1); _Pragma("unroll") for (int m = 0; m < 4; ++m) _Pragma("unroll") for (int n = 0; n < 2; ++n) _Pragma("unroll") for (int k = 0; k < 2; ++k) \
        acc[ai][bj][m][n] = __builtin_amdgcn_mfma_f32_16x16x32_bf16(Bt[n][k], At[m][k], acc[ai][bj][m][n], 0, 0, 0); __builtin_amdgcn_s_setprio(0); } while (0)
#define PG8_WAIT_V(n) asm volatile("s_waitcnt vmcnt(" #n ")" ::: "memory")
#define PG8_WAIT_L(n) asm volatile("s_waitcnt lgkmcnt(" #n ")" ::: "memory")
#define PG8_BAR __builtin_amdgcn_s_barrier()
#define PG8_SCHED __builtin_amdgcn_sched_barrier(0)
    Unit cur, nxt; int ui = 0;
    if (!S.next(0, cur)) return;
    f32x4 acc[2][2][4][2];
#pragma unroll
    for (int a = 0; a < 2; ++a)
#pragma unroll
        for (int b = 0; b < 2; ++b)
#pragma unroll
            for (int m = 0; m < 4; ++m)
#pragma unroll
                for (int n = 0; n < 2; ++n) acc[a][b][m][n] = (f32x4){0.f, 0.f, 0.f, 0.f};
    bf16x8 At[4][2], B0[2][2], B1[2][2];
    const char* cA = (const char*)g.A + (size_t)cur.pm * tstep; const char* cB = (const char*)g.Bt + (size_t)cur.pn * tstep;
    S.a_ready(cur);
    if constexpr (SP2) {
        PG8_STAGE(PG8_SB(0, 0), cB, voffB); PG8_STAGE(PG8_SB(0, 1), cB + hstep, voffB); PG8_STAGE(PG8_SA(0, 0), cA, voffA); PG8_STAGE(PG8_SA(0, 1), cA + hstep, voffA);
        if (wr == 1) PG8_BAR;
        PG8_WAIT_V(2); PG8_BAR;
        PG8_STAGE(PG8_SB(1, 0), cB + kstep, voffB); PG8_STAGE(PG8_SA(1, 0), cA + kstep, voffA); PG8_STAGE(PG8_SB(1, 1), cB + hstep + kstep, voffB);
        PG8_WAIT_V(6); PG8_BAR;
    } else {
        PG8_STAGE(PG8_SB(0, 0), cB, voffB); PG8_STAGE(PG8_SA(0, 0), cA, voffA); PG8_STAGE(PG8_SB(0, 1), cB + hstep, voffB); PG8_STAGE(PG8_SA(0, 1), cA + hstep, voffA);
        if (wr == 1) PG8_BAR;
        PG8_WAIT_V(4); PG8_BAR;
        PG8_STAGE(PG8_SB(1, 0), cB + kstep, voffB); PG8_STAGE(PG8_SA(1, 0), cA + kstep, voffA); PG8_STAGE(PG8_SB(1, 1), cB + hstep + kstep, voffB);
        PG8_WAIT_V(6); PG8_BAR;
    }
    for (;;) {
        const bool has_next = S.next(ui + 1, nxt);
        const char* nA = has_next ? (const char*)g.A + (size_t)nxt.pm * tstep : cA; const char* nB = has_next ? (const char*)g.Bt + (size_t)nxt.pn * tstep : cB;
        for (int t = 0; t < nt; t += 2) {
            const bool last = (t == nt - 2);
            const char* a1 = cA + (size_t)(t + 1) * kstep;
            const char* a2 = last ? nA : cA + (size_t)(t + 2) * kstep; const char* b2 = last ? nB : cB + (size_t)(t + 2) * kstep;
            const char* a3 = a2 + kstep; const char* b3 = b2 + kstep;
            if (last && has_next) S.a_ready(nxt);
            if constexpr (SP2) {
            PG8_LDB(B0, 0, 0); PG8_LDB(B1, 0, 1); PG8_SCHED; PG8_LDA(At, 0, 0); PG8_STAGE(PG8_SA(1, 1), a1 + hstep, voffA);
            PG8_WAIT_V(8); PG8_WAIT_L(0); PG8_BAR; PG8_MMA(0, 0, At, B0); PG8_MMA(0, 1, At, B1); PG8_BAR; PG8_SCHED;
            PG8_LDA(At, 0, 1); PG8_STAGE(PG8_SB(0, 0), b2, voffB); PG8_STAGE(PG8_SB(0, 1), b2 + hstep, voffB); PG8_STAGE(PG8_SA(0, 0), a2, voffA);
            PG8_WAIT_V(8); PG8_WAIT_L(0); PG8_BAR; PG8_MMA(1, 0, At, B0); PG8_MMA(1, 1, At, B1); PG8_BAR; PG8_SCHED;
            PG8_LDB(B0, 1, 0); PG8_LDB(B1, 1, 1); PG8_SCHED; PG8_LDA(At, 1, 0); PG8_STAGE(PG8_SA(0, 1), a2 + hstep, voffA);
            PG8_WAIT_V(8); PG8_WAIT_L(0); PG8_BAR; PG8_MMA(0, 0, At, B0); PG8_MMA(0, 1, At, B1); PG8_BAR; PG8_SCHED;
            PG8_LDA(At, 1, 1); PG8_STAGE(PG8_SB(1, 0), b3, voffB); PG8_STAGE(PG8_SB(1, 1), b3 + hstep, voffB); PG8_STAGE(PG8_SA(1, 0), a3, voffA);
            PG8_WAIT_V(8); PG8_WAIT_L(0); PG8_BAR; PG8_MMA(1, 0, At, B0); PG8_MMA(1, 1, At, B1); PG8_BAR; PG8_SCHED;
            } else {
            PG8_LDB(B0, 0, 0); PG8_SCHED; PG8_LDA(At, 0, 0); PG8_STAGE(PG8_SA(1, 1), a1 + hstep, voffA);
            PG8_WAIT_L(8); PG8_BAR; PG8_WAIT_L(0); PG8_MMA(0, 0, At, B0); PG8_BAR; PG8_SCHED;
            PG8_LDB(B1, 0, 1); PG8_STAGE(PG8_SB(0, 0), b2, voffB);
            PG8_BAR; PG8_WAIT_L(0); PG8_MMA(0, 1, At, B1); PG8_BAR;
            PG8_LDA(At, 0, 1); PG8_STAGE(PG8_SA(0, 0), a2, voffA);
            PG8_BAR; PG8_WAIT_L(0); PG8_MMA(1, 0, At, B0); PG8_BAR; PG8_SCHED;
            PG8_STAGE(PG8_SB(0, 1), b2 + hstep, voffB);
            PG8_WAIT_V(6); PG8_BAR; PG8_MMA(1, 1, At, B1); PG8_BAR;
            PG8_LDB(B0, 1, 0); PG8_SCHED; PG8_LDA(At, 1, 0); PG8_STAGE(PG8_SA(0, 1), a2 + hstep, voffA);
            PG8_WAIT_L(8); PG8_BAR; PG8_WAIT_L(0); PG8_MMA(0, 0, At, B0); PG8_BAR; PG8_SCHED;
            PG8_LDB(B1, 1, 1); PG8_STAGE(PG8_SB(1, 0), b3, voffB);
            PG8_BAR; PG8_WAIT_L(0); PG8_MMA(0, 1, At, B1); PG8_BAR;
            PG8_LDA(At, 1, 1); PG8_STAGE(PG8_SA(1, 0), a3, voffA);
            PG8_BAR; PG8_WAIT_L(0); PG8_MMA(1, 0, At, B0); PG8_BAR; PG8_SCHED;
            PG8_STAGE(PG8_SB(1, 1), b3 + hstep, voffB);
            PG8_WAIT_V(6); PG8_BAR; PG8_MMA(1, 1, At, B1); PG8_BAR;
            }
        }
        if constexpr (ALIGN_EPI) { if (wr == 0) PG8_BAR; }
        if constexpr (!Epi::AFTER_DRAIN) { E(acc, cur, wr, wc, fr, fq); S.done(cur); }
        if (!has_next) break;
#pragma unroll
        for (int a = 0; a < 2; ++a)
#pragma unroll
            for (int b = 0; b < 2; ++b)
#pragma unroll
                for (int m = 0; m < 4; ++m)
#pragma unroll
                    for (int n = 0; n < 2; ++n) acc[a][b][m][n] = (f32x4){0.f, 0.f, 0.f, 0.f};
        cur = nxt; cA = nA; cB = nB; ++ui;
        if constexpr (ALIGN_EPI) { if (wr == 1) PG8_BAR; }
    }
    PG8_WAIT_V(0);
    if constexpr (!ALIGN_EPI) { if (wr == 0) PG8_BAR; }
    PG8_BAR;
    if constexpr (Epi::AFTER_DRAIN) { E.fused(acc, cur, wr, wc, fr, fq, lds, wid, lane); S.done(cur); }
#undef PG8_SA
#undef PG8_SB
#undef PG8_STAGE
#undef PG8_LDA
#undef PG8_LDB
#undef PG8_MMA
#undef PG8_WAIT_V
#undef PG8_WAIT_L
#undef PG8_BAR
#undef PG8_SCHED
}
}

namespace mk {
using pg8::bf16_t; using pg8::bf16x8; using pg8::f32x4; using pg8::u32x4;
typedef float f32x16 __attribute__((ext_vector_type(16)));
typedef short s16x4 __attribute__((ext_vector_type(4)));
typedef short v4i16_t __attribute__((ext_vector_type(4)));
typedef unsigned u32x2 __attribute__((ext_vector_type(2)));
typedef float f32x2_t __attribute__((ext_vector_type(2)));
typedef __bf16 bf16x2_t __attribute__((ext_vector_type(2)));
#define LAS __attribute__((address_space(3)))

constexpr int MP = 65536, MT = 65792;
constexpr size_t MiB = 1u << 20;
constexpr size_t WS_SS = 0, WS_W = 4 * MiB, WS_XB = 166 * MiB, WS_UN = 295 * MiB, WS_QO = WS_UN, WS_KP = 424 * MiB, WS_VP = 520 * MiB, WS_KBP = 649 * MiB, WS_VBP = 745 * MiB,
                 WS_MEMB = WS_KBP, WS_KS = 841 * MiB, WS_VS = 866 * MiB, WS_KBS = 891 * MiB, WS_VBS = 898 * MiB, WS_MKV = 905 * MiB, WS_MKS = 937 * MiB, WS_MVS = 941 * MiB, WS_END = 945 * MiB;
constexpr size_t SS_STRIDE = 65792, SS_MEM = 13 * SS_STRIDE;
constexpr size_t WS_BAR = 4 * MiB - 65536, BAR_BYTES = 16384;
static_assert((SS_MEM + 8192 + 65792) * 4 <= WS_BAR, "barrier words clear of the ss rows");
constexpr size_t W_L = 17301504, W_GU1 = 0, W_D1 = 5767168, W_GU2 = 8650752, W_D2 = 14417920;
constexpr size_t W_INA = 69206016, W_INB = 74448896, W_OUT = 76546048, W_MEM = 80740352, W_KVB = 82837504, W_END = 84410368;
static_assert(WS_W + W_END * 2 <= WS_XB && WS_XB + (size_t)MT * 1024 * 2 <= WS_UN && WS_UN + (size_t)MT * 2816 * 2 <= WS_KBP && WS_QO + (size_t)MT * 1024 * 2 <= WS_KP, "ws map");
constexpr size_t KS_L = (size_t)8 * 1056 * 768;
constexpr int LDS_BYTES = 147456;
constexpr float LOG2E = 1.4426950408889634f;

struct Args { const float* in[25]; float* out; unsigned char* ws; };

__device__ __forceinline__ unsigned pk(float lo, float hi) { f32x2_t v = {lo, hi}; bf16x2_t b = __builtin_convertvector(v, bf16x2_t); return __builtin_bit_cast(unsigned, b); }
__device__ __forceinline__ int opaque_tid() { int t = threadIdx.x; asm volatile("" : "+v"(t)); return t; }
__device__ __forceinline__ float wave_sum(float v) {
#pragma unroll
    for (int o = 1; o < 64; o <<= 1) v += __shfl_xor(v, o);
    return v;
}

__device__ __forceinline__ void conv_item(const float* __restrict__ W, int K, int N, bf16_t* WT, int rowoff, const float* __restrict__ g, bool gumap, LAS float* scr, int item, int lane) {
    const int nblk = N / 32, kb = item / nblk, nb = item - kb * nblk, k0 = 64 * kb, n0 = 32 * nb;
    float v[32];
#pragma unroll
    for (int i = 0; i < 32; ++i) v[i] = W[(size_t)(k0 + 2 * i + (lane >> 5)) * N + n0 + (lane & 31)];
    if (g) {
#pragma unroll
        for (int i = 0; i < 32; ++i) v[i] *= g[k0 + 2 * i + (lane >> 5)];
    }
#pragma unroll
    for (int i = 0; i < 32; ++i) scr[(2 * i + (lane >> 5)) * 33 + (lane & 31)] = v[i];
    asm volatile("s_waitcnt lgkmcnt(0)" ::: "memory");
    const int c = lane & 7;
#pragma unroll
    for (int j = 0; j < 4; ++j) {
        const int n = (lane >> 3) + 8 * j; const LAS float* sp = scr + (8 * c) * 33 + n;
        u32x4 o; o.x = pk(sp[0], sp[33]); o.y = pk(sp[66], sp[99]); o.z = pk(sp[132], sp[165]); o.w = pk(sp[198], sp[231]);
        const int nn = n0 + n; int drow = nn;
        if (gumap) { const int half = nn >= 2816 ? 1 : 0, jn = nn - half * 2816; drow = (jn >> 7) * 256 + half * 128 + (jn & 127); }
        *(u32x4*)(WT + (size_t)(rowoff + drow) * K + k0 + 8 * c) = o;
    }
    asm volatile("s_waitcnt lgkmcnt(0)" ::: "memory");
}
__device__ __forceinline__ void conv_w(const float* __restrict__ src, int K, int N, bf16_t* dst, int rowoff, const float* __restrict__ g, bool gumap, LAS float* scr, int gw, int NGW, int lane, int& base) {
    const int nitems = (K / 64) * (N / 32);
    int first = gw - base; if (first < 0) first += NGW;
    for (int it = first; it < nitems; it += NGW) conv_item(src, K, N, dst, rowoff, g, gumap, scr, it, lane);
    base = (base + nitems) % NGW;
}
__device__ __forceinline__ void row1024(const float* src, float* ycopy, bf16_t* xb, float* ssq, int lane) {
    f32x4 v[4]; float s = 0.f;
#pragma unroll
    for (int j = 0; j < 4; ++j) { v[j] = ((const f32x4*)src)[lane + 64 * j]; s += (v[j][0] * v[j][0] + v[j][1] * v[j][1]) + (v[j][2] * v[j][2] + v[j][3] * v[j][3]); }
    s = wave_sum(s);
#pragma unroll
    for (int j = 0; j < 4; ++j) {
        if (ycopy) ((f32x4*)ycopy)[lane + 64 * j] = v[j];
        u32x2 o; o.x = pk(v[j][0], v[j][1]); o.y = pk(v[j][2], v[j][3]); ((u32x2*)xb)[lane + 64 * j] = o;
    }
    if (lane == 0) *ssq = s;
}
__device__ __forceinline__ void cvt_rows(const float* src, bf16_t* dst, int nrows, int rowlen, int srg, int drg, int gw, int NGW, int lane) {
    for (int row = gw; row < nrows; row += NGW) {
        const int g = row / srg, t = row - g * srg; const size_t drow = (size_t)g * drg + t;
        for (int c = 0; c < rowlen; c += 256) {
            const f32x4 v = *(const f32x4*)(src + (size_t)row * rowlen + c + 4 * lane);
            u32x2 o; o.x = pk(v[0], v[1]); o.y = pk(v[2], v[3]); *(u32x2*)(dst + drow * rowlen + c + 4 * lane) = o;
        }
    }
}

__device__ __forceinline__ s16x4 vtr(const LAS unsigned char* p) { return __builtin_bit_cast(s16x4, __builtin_amdgcn_ds_read_tr16_b64_v4i16((LAS v4i16_t*)p)); }
#define MFMA32(a, b, c) __builtin_amdgcn_mfma_f32_32x32x16_bf16((a), (b), (c), 0, 0, 0)

struct AttnState { f32x16 o0, o1; float carry, mrun, lsum; };
template <int MODE>
__device__ __forceinline__ void attn_tile(AttnState& S, const bf16x8 (&qf)[4], const bf16x8 (&kf)[4], const u32x4 (&vr)[4], int k0i, int qpos0, int kpos0,
                                          LAS unsigned char* vwp, const LAS unsigned char* trp, const LAS float* biasT, int r, int h) {
    const float SC = 0.125f * LOG2E;
    f32x16 st;
#pragma unroll
    for (int i = 0; i < 16; ++i) st[i] = 0.f;
#pragma unroll
    for (int s = 0; s < 4; ++s) st = MFMA32(kf[s], qf[s], st);
#pragma unroll
    for (int i = 0; i < 4; ++i) *(LAS u32x4*)(vwp + i * 8 * 144) = vr[i];
    const int dlim = (qpos0 + r) - (kpos0 + k0i) - 4 * h;
    float p[16];
    if constexpr (MODE == 0) {
        float z2[16], lk[16];
#pragma unroll
        for (int i = 0; i < 16; ++i) {
            const int ci = (i & 3) + 8 * (i >> 2);
            z2[i] = st[i] * SC;
            const float t = __builtin_amdgcn_exp2f(-__builtin_fabsf(z2[i]));
            const float sp = __builtin_fmaxf(z2[i], 0.f) + __builtin_amdgcn_logf(1.0f + t);
            lk[i] = (ci < dlim) ? -sp : 0.f;
        }
        float G[4], GP[4];
#pragma unroll
        for (int c = 0; c < 4; ++c) { G[c] = (lk[4 * c] + lk[4 * c + 1]) + (lk[4 * c + 2] + lk[4 * c + 3]); GP[c] = __shfl_xor(G[c], 32); }
        float OS[4], PSE[4], PSI[4];
        OS[3] = 0.f; OS[2] = G[3]; OS[1] = OS[2] + G[2]; OS[0] = OS[1] + G[1];
        PSE[3] = 0.f; PSE[2] = GP[3]; PSE[1] = PSE[2] + GP[2]; PSE[0] = PSE[1] + GP[1];
#pragma unroll
        for (int c = 0; c < 4; ++c) PSI[c] = PSE[c] + GP[c];
#pragma unroll
        for (int c = 0; c < 4; ++c) {
            float aft = S.carry + OS[c] + (h == 0 ? PSI[c] : PSE[c]);
#pragma unroll
            for (int jj = 3; jj >= 0; --jj) {
                const int i = 4 * c + jj; const int ci = (i & 3) + 8 * (i >> 2);
                const float w = __builtin_amdgcn_exp2f(z2[i] + lk[i] + aft);
                p[i] = (ci < dlim) ? w : 0.f;
                aft += lk[i];
            }
        }
        S.carry += (OS[0] + G[0]) + PSI[0];
    } else {
        float s2[16]; float mt = -__builtin_inff();
        const bool farb = (MODE == 1) && ((qpos0 - (kpos0 + k0i) - 31) >= 128);
        const float bfar = (MODE == 1) ? biasT[256] : 0.f;
#pragma unroll
        for (int i = 0; i < 16; ++i) {
            s2[i] = st[i] * SC;
            if constexpr (MODE == 1) {
                if (farb) s2[i] += bfar;
                else { const int ci = (i & 3) + 8 * (i >> 2); int idx = dlim - ci + 128; idx = idx < 0 ? 0 : (idx > 256 ? 256 : idx); s2[i] += biasT[idx]; }
            }
            mt = __builtin_fmaxf(mt, s2[i]);
        }
        mt = __builtin_fmaxf(mt, __shfl_xor(mt, 32));
        const float mnew = __builtin_fmaxf(S.mrun, mt);
        const float alpha = __builtin_amdgcn_exp2f(S.mrun - mnew);
        float ps = 0.f;
#pragma unroll
        for (int i = 0; i < 16; ++i) { p[i] = __builtin_amdgcn_exp2f(s2[i] - mnew); ps += p[i]; }
        S.lsum = S.lsum * alpha + ps; S.mrun = mnew;
#pragma unroll
        for (int i = 0; i < 16; ++i) { S.o0[i] *= alpha; S.o1[i] *= alpha; }
    }
    bf16x8 pb[2], va[2][2];
#pragma unroll
    for (int s2i = 0; s2i < 2; ++s2i) {
        u32x4 pw; pw.x = pk(p[8 * s2i], p[8 * s2i + 1]); pw.y = pk(p[8 * s2i + 2], p[8 * s2i + 3]); pw.z = pk(p[8 * s2i + 4], p[8 * s2i + 5]); pw.w = pk(p[8 * s2i + 6], p[8 * s2i + 7]);
        pb[s2i] = __builtin_bit_cast(bf16x8, pw);
#pragma unroll
        for (int blk = 0; blk < 2; ++blk) {
            const s16x4 lo = vtr(trp + s2i * 2304 + blk * 64), hi = vtr(trp + s2i * 2304 + 1152 + blk * 64);
            va[s2i][blk] = __builtin_shufflevector(lo, hi, 0, 1, 2, 3, 4, 5, 6, 7);
        }
    }
#pragma unroll
    for (int s2i = 0; s2i < 2; ++s2i) { S.o0 = MFMA32(va[s2i][0], pb[s2i], S.o0); S.o1 = MFMA32(va[s2i][1], pb[s2i], S.o1); }
}

template <int MODE>
__device__ __forceinline__ void attn_unit(const bf16_t* Q, const bf16_t* K, const bf16_t* V, bf16_t* O, int kp, int kt_lo, int kt_hi, int qpos0, int kpos0,
                                          LAS unsigned char* vl, const LAS float* biasT, int lane) {
    const int r = lane & 31, h = lane >> 5;
    bf16x8 qf[4];
#pragma unroll
    for (int s = 0; s < 4; ++s) qf[s] = *(const bf16x8*)(Q + (unsigned)(r * 1024 + 16 * s + 8 * h));
    AttnState S;
#pragma unroll
    for (int i = 0; i < 16; ++i) { S.o0[i] = 0.f; S.o1[i] = 0.f; }
    S.carry = 0.f; S.mrun = -__builtin_inff(); S.lsum = 0.f;
    const int nt = kt_hi - kt_lo + 1;
    const int vkey = lane >> 3, vseg = lane & 7;
    const int c16 = (lane >> 4) & 1, q4 = (lane & 15) >> 2, p4 = lane & 3;
    const LAS unsigned char* trp = vl + (4 * h + q4) * 144 + 32 * c16 + 8 * p4;
    LAS unsigned char* vwp = vl + vkey * 144 + vseg * 16;
    const unsigned koff = (unsigned)(r * kp + 8 * h), voff = (unsigned)(vkey * kp + vseg * 8), kp8 = (unsigned)(8 * kp);
    const int step = (MODE == 0) ? -1 : 1;
    int kt = (MODE == 0) ? kt_hi : kt_lo;
    bf16x8 kA[4], kB[4]; u32x4 vA[4], vB[4];
#define ATT_LOAD(kk, vv, ktile) do { const int _kt = (ktile) < kt_lo ? kt_lo : ((ktile) > kt_hi ? kt_hi : (ktile)); \
        const bf16_t* Kt = K + (size_t)_kt * 32 * kp; const bf16_t* Vt = V + (size_t)_kt * 32 * kp; \
        _Pragma("unroll") for (int s = 0; s < 4; ++s) kk[s] = *(const bf16x8*)(Kt + (koff + 16 * s)); \
        _Pragma("unroll") for (int i = 0; i < 4; ++i) vv[i] = *(const u32x4*)(Vt + (voff + i * kp8)); } while (0)
#define ATT_DONE() (MODE == 0 && __builtin_amdgcn_ballot_w64(S.carry > -150.0f) == 0ull)
    ATT_LOAD(kA, vA, kt);
    int it = 0;
    for (; it + 1 < nt; it += 2) {
        ATT_LOAD(kB, vB, kt + step);
        attn_tile<MODE>(S, qf, kA, vA, kt * 32, qpos0, kpos0, vwp, trp, biasT, r, h);
        if (ATT_DONE()) { it = nt; break; }
        ATT_LOAD(kA, vA, kt + 2 * step);
        attn_tile<MODE>(S, qf, kB, vB, (kt + step) * 32, qpos0, kpos0, vwp, trp, biasT, r, h);
        kt += 2 * step;
        if (ATT_DONE()) { it = nt; break; }
    }
    if (it < nt) attn_tile<MODE>(S, qf, kA, vA, kt * 32, qpos0, kpos0, vwp, trp, biasT, r, h);
#undef ATT_LOAD
#undef ATT_DONE
    float inv = 1.0f;
    if constexpr (MODE != 0) { const float l = S.lsum + __shfl_xor(S.lsum, 32); inv = 1.0f / l; }
#pragma unroll
    for (int c = 0; c < 4; ++c) {
        u32x2 a, b;
        a.x = pk(S.o0[4 * c] * inv, S.o0[4 * c + 1] * inv); a.y = pk(S.o0[4 * c + 2] * inv, S.o0[4 * c + 3] * inv);
        b.x = pk(S.o1[4 * c] * inv, S.o1[4 * c + 1] * inv); b.y = pk(S.o1[4 * c + 2] * inv, S.o1[4 * c + 3] * inv);
        *(u32x2*)(O + (unsigned)(r * 1024 + 8 * c + 4 * h)) = a;
        *(u32x2*)(O + (unsigned)(r * 1024 + 32 + 8 * c + 4 * h)) = b;
    }
}

struct SmpEpi { int mode; const float* ss; bf16_t* H; bf16_t* XB; float* ssn; float sc; pg8::ProjCtx pc; };
__device__ __forceinline__ void sample_gemm(const bf16_t* A, const bf16_t* Wt, int N, int K, const SmpEpi& E) {
    const int tid = opaque_tid(), lane = tid & 63, wid = __builtin_amdgcn_readfirstlane(tid >> 6);
    const int r = lane & 31, h = lane >> 5;
    const int gwm = wid * gridDim.x + blockIdx.x, NGW = gridDim.x * 8;
    const int ncb = (E.mode == 0) ? 88 : N / 64, nunits = 8 * ncb, nch = K / 32;
    const unsigned loff = (unsigned)(r * K + 16 * h);
    for (int wu = gwm; wu < nunits; wu += NGW) {
        const int rb = wu & 7, cb = wu >> 3;
        int w0, w1;
        if (E.mode == 0) { const int hc0 = 32 * cb; w0 = 256 * (hc0 >> 7) + (hc0 & 127); w1 = w0 + 128; } else { w0 = 64 * cb; w1 = w0 + 32; }
        const bf16_t* pa = A + (size_t)(rb * 32) * K; const bf16_t* pw0 = Wt + (size_t)w0 * K; const bf16_t* pw1 = Wt + (size_t)w1 * K;
        f32x16 c0, c1;
#pragma unroll
        for (int i = 0; i < 16; ++i) { c0[i] = 0.f; c1[i] = 0.f; }
        constexpr int D = 4;
        bf16x8 xa[D][2], wa[D][2], wb[D][2];
#pragma unroll
        for (int d = 0; d < D; ++d) {
            const unsigned o = loff + d * 32;
            xa[d][0] = *(const bf16x8*)(pa + o); xa[d][1] = *(const bf16x8*)(pa + o + 8);
            wa[d][0] = *(const bf16x8*)(pw0 + o); wa[d][1] = *(const bf16x8*)(pw0 + o + 8);
            wb[d][0] = *(const bf16x8*)(pw1 + o); wb[d][1] = *(const bf16x8*)(pw1 + o + 8);
        }
        for (int ch = 0; ch < nch; ch += D) {
#pragma unroll
            for (int d = 0; d < D; ++d) {
                c0 = MFMA32(wa[d][0], xa[d][0], c0); c1 = MFMA32(wb[d][0], xa[d][0], c1);
                c0 = MFMA32(wa[d][1], xa[d][1], c0); c1 = MFMA32(wb[d][1], xa[d][1], c1);
                const int nx = ch + d + D;
                if (nx < nch) {
                    const unsigned o = loff + nx * 32;
                    xa[d][0] = *(const bf16x8*)(pa + o); xa[d][1] = *(const bf16x8*)(pa + o + 8);
                    wa[d][0] = *(const bf16x8*)(pw0 + o); wa[d][1] = *(const bf16x8*)(pw0 + o + 8);
                    wb[d][0] = *(const bf16x8*)(pw1 + o); wb[d][1] = *(const bf16x8*)(pw1 + o + 8);
                }
            }
        }
        const unsigned rl = rb * 32 + r;
        if (E.mode == 0) {
            const float rs = __builtin_amdgcn_rsqf(E.ss[MP + rl] * (1.0f / 1024.0f) + 1e-6f);
            bf16_t* hp = E.H + (size_t)MP * 2816 + (rl * 2816u + 32 * cb + 4 * h);
#pragma unroll
            for (int c = 0; c < 4; ++c) {
                float hv[4];
#pragma unroll
                for (int j = 0; j < 4; ++j) { const float g = c0[4 * c + j] * rs, up = c1[4 * c + j] * rs; hv[j] = g * up * __builtin_amdgcn_rcpf(1.0f + __expf(-g)); }
                u32x2 o; o.x = pk(hv[0], hv[1]); o.y = pk(hv[2], hv[3]); *(u32x2*)(hp + 8 * c) = o;
            }
        } else if (E.mode == 1) {
            float part = 0.f;
            bf16_t* bp = E.XB + (size_t)MP * 1024 + (rl * 1024u + 64 * cb + 4 * h);
            u32x2 win[2][4];
#pragma unroll
            for (int blk = 0; blk < 2; ++blk)
#pragma unroll
                for (int c = 0; c < 4; ++c) win[blk][c] = *(const u32x2*)(bp + 32 * blk + 8 * c);
#pragma unroll
            for (int blk = 0; blk < 2; ++blk)
#pragma unroll
                for (int c = 0; c < 4; ++c) {
                    const u32x2 w = win[blk][c];
                    f32x4 x; x[0] = __builtin_bit_cast(float, w.x << 16); x[1] = __builtin_bit_cast(float, w.x & 0xffff0000u); x[2] = __builtin_bit_cast(float, w.y << 16); x[3] = __builtin_bit_cast(float, w.y & 0xffff0000u);
#pragma unroll
                    for (int j = 0; j < 4; ++j) { x[j] += E.sc * (blk ? c1[4 * c + j] : c0[4 * c + j]); part += x[j] * x[j]; }
                    u32x2 o; o.x = pk(x[0], x[1]); o.y = pk(x[2], x[3]); *(u32x2*)(bp + 32 * blk + 8 * c) = o;
                }
            part += __shfl_xor(part, 32);
            if (h == 0) unsafeAtomicAdd(E.ssn + MP + rl, part);
        } else {
            const float rs = __builtin_amdgcn_rsqf(E.ss[MP + rl] * (1.0f / 1024.0f) + 1e-6f);
#pragma unroll
            for (int blk = 0; blk < 2; ++blk) {
                const int n0 = 64 * cb + 32 * blk;
                pg8::Unit u; u.pm = 256; u.pn = n0 >> 8;
                const pg8::Route rt = pg8::route_unit(E.pc, u);
                const unsigned rbw = rt.grp ? (rl >> 5) * (unsigned)rt.grp + (rl & 31u) : rl, cl = (unsigned)(n0 & 255) + 4 * h;
#pragma unroll
                for (int c = 0; c < 4; ++c) {
                    f32x4 v;
#pragma unroll
                    for (int j = 0; j < 4; ++j) v[j] = (blk ? c1[4 * c + j] : c0[4 * c + j]) * rs;
                    if (rt.b) { u32x2 o; o.x = pk(v[0], v[1]); o.y = pk(v[2], v[3]); *(u32x2*)(rt.b + (rbw * (unsigned)rt.ldb + cl + 8 * c)) = o; }
                    if (rt.f) *(f32x4*)(rt.f + (rl * (unsigned)rt.ldf + cl + 8 * c)) = v;
                }
            }
        }
    }
}

#define XB_TMO      128
#define XB_XCNT(j)  (256  + 64 * (j))
#define XB_XSUB(j)  (1280 + 64 * (j))
#define XB_XGEN(j)  (2304 + 64 * (j))
#define XB_TOP      3328
#define XB_TOPGEN   3392
#define XCD_BAR_WORDS 3456
#define XB_SPIN_CAP (1u << 18)

__device__ __forceinline__ unsigned xb_ld(unsigned* p)              { return __hip_atomic_load(p, __ATOMIC_RELAXED, __HIP_MEMORY_SCOPE_AGENT); }
__device__ __forceinline__ unsigned xb_add(unsigned* p, unsigned v) { return __hip_atomic_fetch_add(p, v, __ATOMIC_RELAXED, __HIP_MEMORY_SCOPE_AGENT); }
__device__ __forceinline__ unsigned xb_xcc_id() { return (unsigned)__builtin_amdgcn_s_getreg((3 << 11) | 20) & 0xFu; }
#define XB_SPIN(cond, bar) do { unsigned _sp = 0; while (cond) { __builtin_amdgcn_s_sleep(1); \
    if ((++_sp & 255u) == 0u) { if (xb_ld(&(bar)[XB_TMO])) break; if (_sp > XB_SPIN_CAP) { atomicAdd(&(bar)[XB_TMO], 1u); break; } } } } while (0)

struct XcdBarrier {
    unsigned* bar; unsigned x;
    volatile LAS unsigned* st;
};

__device__ __forceinline__ XcdBarrier xcd_barrier_post(unsigned* bar, volatile LAS unsigned* st) {
    XcdBarrier b; b.bar = bar; b.x = xb_xcc_id(); b.st = st;
    if (threadIdx.x == 0) (void)xb_add(&bar[XB_XCNT(b.x)], 1u);
    return b;
}
__device__ __forceinline__ void xcd_barrier_complete(unsigned* bar, unsigned x, unsigned& nloc, unsigned& nx) {
    const unsigned G = gridDim.x * gridDim.y * gridDim.z;
    unsigned sum, cnt, mine, sp = 0u;
    for (;;) {
        sum = 0u; cnt = 0u; mine = 0u;
#pragma unroll
        for (unsigned j = 0; j < 16; ++j) { const unsigned c = xb_ld(&bar[XB_XCNT(j)]); sum += c; cnt += (c > 0u) ? 1u : 0u; mine = (j == x) ? c : mine; }
        if (sum == G) break;
        __builtin_amdgcn_s_sleep(1);
        if ((++sp & 255u) == 0u) { if (xb_ld(&bar[XB_TMO])) break; if (sp > XB_SPIN_CAP) { atomicAdd(&bar[XB_TMO], 1u); break; } }
    }
    nloc = mine > 0u ? mine : 1u; nx = cnt > 0u ? cnt : 1u;
}

__device__ __forceinline__ void xcd_barrier(const XcdBarrier& b) {
    asm volatile("s_waitcnt vmcnt(0)" ::: "memory");
    __syncthreads();
    if (threadIdx.x == 0) {
        unsigned* bar = b.bar;
        __builtin_amdgcn_s_waitcnt(0);
        unsigned nloc = b.st[0], nx = b.st[1];
        if (nloc == 0u) { xcd_barrier_complete(bar, b.x, nloc, nx); b.st[0] = nloc; b.st[1] = nx; }
        const unsigned old = xb_add(&bar[XB_XSUB(b.x)], 1u);
        const unsigned gen = old / nloc;
        if (old + 1u == (gen + 1u) * nloc) {
            __builtin_amdgcn_fence(__ATOMIC_RELEASE, "agent");
            asm volatile("s_waitcnt vmcnt(0)" ::: "memory");
            const unsigned og = xb_add(&bar[XB_TOP], 1u);
            const unsigned tg = og / nx;
            if (og + 1u == (tg + 1u) * nx) xb_add(&bar[XB_TOPGEN], 1u);
            else XB_SPIN(xb_ld(&bar[XB_TOPGEN]) == tg, bar);
            __builtin_amdgcn_fence(__ATOMIC_ACQUIRE, "agent");
            xb_add(&bar[XB_XGEN(b.x)], 1u);
            asm volatile("s_waitcnt vmcnt(0)" ::: "memory");
        } else {
            XB_SPIN(xb_ld(&bar[XB_XGEN(b.x)]) == gen, bar);
            __builtin_amdgcn_fence(__ATOMIC_ACQUIRE, "agent");
            asm volatile("s_waitcnt vmcnt(0)" ::: "memory");
        }
    }
    __syncthreads();
}


struct Ptrs {
    float* out; float* ss;
    bf16_t *W, *XB, *HID, *QO, *Kp, *Vp, *KBp, *VBp, *MEMB, *Ks, *Vs, *KBs, *VBs, *MKV, *MKS, *MVS;
};

__device__ __forceinline__ void attn_phase(const Ptrs& P, int l, const float* relb, LAS unsigned char* lds) {
    const int tid = opaque_tid(), lane = tid & 63, wid = __builtin_amdgcn_readfirstlane(tid >> 6);
    LAS unsigned char* vl = lds + wid * 4608;
    LAS float* biasL = (LAS float*)(lds + 40960);
    if (l >= 2) {
        for (int i = tid; i < 12 * 257; i += 512) biasL[i] = relb[(size_t)(l - 2) * 12 * 257 + i] * LOG2E;
        __syncthreads();
    }
    constexpr int NW1 = 3072, NW3 = 1024, NS = 128;
    const int gwm = wid * gridDim.x + blockIdx.x;
    const int nrounds = (NW1 + NW3 + (int)gridDim.x - 1) / (int)gridDim.x;
    for (int it = -1; it < nrounds; ++it) {
        const bf16_t *K, *V; bf16_t* Q; int kp = 768, kt_lo = 0, kt_hi = 0, qpos0 = 0, kpos0 = 0, mode, hd = 0;
        if (it < 0) {
            if (gwm >= NS) continue;
            if (gwm < 96) {
                const int b = gwm / 12; hd = gwm - b * 12;
                Q = P.QO + ((size_t)MP + 32 * b) * 1024 + hd * 64; qpos0 = 1024;
                if (l < 2) { mode = 0; K = P.Ks + (size_t)l * KS_L + (size_t)b * 1056 * 768 + hd * 64; V = P.Vs + (size_t)l * KS_L + (size_t)b * 1056 * 768 + hd * 64; kt_hi = 32; }
                else { mode = 1; K = P.KBs + (size_t)b * 544 * 768 + hd * 64; V = P.VBs + (size_t)b * 544 * 768 + hd * 64; kt_hi = 16; kpos0 = 512; }
            } else {
                const int v = gwm - 96, b = v >> 2, mh = v & 3;
                mode = 2; Q = P.QO + ((size_t)MP + 32 * b) * 1024 + 768 + mh * 64;
                K = P.MKS + ((size_t)(l * 8 + b) * 256) * 256 + mh * 64; V = P.MVS + ((size_t)(l * 8 + b) * 256) * 256 + mh * 64; kp = 256; kt_hi = 7;
            }
        } else {
            const int wu = it * (int)gridDim.x + (int)blockIdx.x;
            if (wu >= NW1 + NW3) continue;
            if (wu < NW1) {
                const int qb8 = wu / 384, bh = wu - qb8 * 384, qb = 8 * qb8 + wid, b = bh / 12; hd = bh - b * 12;
                Q = P.QO + ((size_t)b * 2048 + 32 * qb) * 1024 + hd * 64; qpos0 = 32 * qb;
                if (l < 2) { mode = 0; K = P.Kp + (size_t)b * 2048 * 768 + hd * 64; V = P.Vp + (size_t)b * 2048 * 768 + hd * 64; kt_hi = qb; }
                else { mode = 1; const int c = qb >> 1; K = P.KBp + (size_t)b * 2048 * 768 + hd * 64; V = P.VBp + (size_t)b * 2048 * 768 + hd * 64; kt_lo = c > 8 ? 2 * (c - 8) : 0; kt_hi = 2 * c + 1; }
            } else {
                const int v = wu - NW1, qb8 = v >> 7, bh = v & 127, b = bh >> 2, mh = bh & 3, qb = 8 * qb8 + wid;
                mode = 2; Q = P.QO + ((size_t)b * 2048 + 32 * qb) * 1024 + 768 + mh * 64;
                K = P.MKV + (size_t)b * 256 * 2048 + l * 512 + mh * 64; V = K + 256; kp = 2048; kt_hi = 7;
            }
        }
        if (mode == 0) attn_unit<0>(Q, K, V, Q, kp, kt_lo, kt_hi, qpos0, kpos0, vl, biasL, lane);
        else if (mode == 1) attn_unit<1>(Q, K, V, Q, kp, kt_lo, kt_hi, qpos0, kpos0, vl, biasL + hd * 257, lane);
        else attn_unit<2>(Q, K, V, Q, kp, kt_lo, kt_hi, qpos0, kpos0, vl, biasL, lane);
    }
    __syncthreads();
}

__global__ void __launch_bounds__(512) yoco_fwd(Args a) {
    extern __shared__ __attribute__((aligned(16))) unsigned char smem[];
    LAS unsigned char* lds = (LAS unsigned char*)smem;
    cg::grid_group grid = cg::this_grid();
    const int G = gridDim.x, NGW = G * 8;
    unsigned char* ws = a.ws;
    Ptrs P;
    P.out = a.out; P.ss = (float*)(ws + WS_SS);
    P.W = (bf16_t*)(ws + WS_W); P.XB = (bf16_t*)(ws + WS_XB); P.HID = (bf16_t*)(ws + WS_UN); P.QO = (bf16_t*)(ws + WS_QO); P.Kp = (bf16_t*)(ws + WS_KP); P.Vp = (bf16_t*)(ws + WS_VP);
    P.KBp = (bf16_t*)(ws + WS_KBP); P.VBp = (bf16_t*)(ws + WS_VBP); P.MEMB = (bf16_t*)(ws + WS_MEMB); P.Ks = (bf16_t*)(ws + WS_KS); P.Vs = (bf16_t*)(ws + WS_VS);
    P.KBs = (bf16_t*)(ws + WS_KBS); P.VBs = (bf16_t*)(ws + WS_VBS); P.MKV = (bf16_t*)(ws + WS_MKV); P.MKS = (bf16_t*)(ws + WS_MKS); P.MVS = (bf16_t*)(ws + WS_MVS);
    volatile LAS unsigned* bst = (volatile LAS unsigned*)(lds + LDS_BYTES - 64);
    if (threadIdx.x == 0) { bst[0] = 0u; bst[1] = 0u; }
    __syncthreads();
    const XcdBarrier xbar = xcd_barrier_post((unsigned*)(ws + WS_BAR), bst);
    float* Y = a.out;

    {
        const int tid = opaque_tid(), lane = tid & 63, wid = __builtin_amdgcn_readfirstlane(tid >> 6), gw = blockIdx.x * 8 + wid;
        LAS float* scr = (LAS float*)(lds + wid * 8448); int cbase = 0;
        for (int l = 0; l < 4; ++l) {
            bf16_t* wl = P.W + (size_t)l * W_L;
            conv_w(a.in[10] + (size_t)l * 1024 * 5632, 1024, 5632, wl + W_GU1, 0, a.in[9] + l * 1024, true, scr, gw, NGW, lane, cbase);
            conv_w(a.in[11] + (size_t)l * 2816 * 1024, 2816, 1024, wl + W_D1, 0, nullptr, false, scr, gw, NGW, lane, cbase);
            conv_w(a.in[22] + (size_t)l * 1024 * 5632, 1024, 5632, wl + W_GU2, 0, a.in[21] + l * 1024, true, scr, gw, NGW, lane, cbase);
            conv_w(a.in[23] + (size_t)l * 2816 * 1024, 2816, 1024, wl + W_D2, 0, nullptr, false, scr, gw, NGW, lane, cbase);
            conv_w(a.in[15] + (size_t)l * 1024 * 1024, 1024, 1024, P.W + W_OUT + (size_t)l * 1048576, 0, nullptr, false, scr, gw, NGW, lane, cbase);
            conv_w(a.in[17] + (size_t)l * 1024 * 512, 1024, 512, P.W + W_MEM, l * 512, a.in[16] + l * 1024, false, scr, gw, NGW, lane, cbase);
            if (l < 2) conv_w(a.in[13] + (size_t)l * 1024 * 2560, 1024, 2560, P.W + W_INA + (size_t)l * 2621440, 0, a.in[12] + l * 1024, false, scr, gw, NGW, lane, cbase);
            else       conv_w(a.in[14] + (size_t)(l - 2) * 1024 * 1024, 1024, 1024, P.W + W_INB + (size_t)(l - 2) * 1048576, 0, a.in[12] + l * 1024, false, scr, gw, NGW, lane, cbase);
        }
        conv_w(a.in[19], 1024, 1536, P.W + W_KVB, 0, a.in[18], false, scr, gw, NGW, lane, cbase);
        for (int row = gw; row < MT; row += 4 * NGW) {
            f32x4 v[4][4]; float sq[4];
#pragma unroll
            for (int q = 0; q < 4; ++q) { const int rw = row + q * NGW; sq[q] = 0.f;
                if (rw < MT) { const float* src = rw < MP ? a.in[0] + (size_t)rw * 1024 : a.in[1] + (size_t)(rw - MP) * 1024;
#pragma unroll
                    for (int j = 0; j < 4; ++j) v[q][j] = ((const f32x4*)src)[lane + 64 * j]; } }
#pragma unroll
            for (int q = 0; q < 4; ++q) { const int rw = row + q * NGW;
                if (rw < MT) {
#pragma unroll
                    for (int j = 0; j < 4; ++j) sq[q] += (v[q][j][0] * v[q][j][0] + v[q][j][1] * v[q][j][1]) + (v[q][j][2] * v[q][j][2] + v[q][j][3] * v[q][j][3]);
                    sq[q] = wave_sum(sq[q]);
#pragma unroll
                    for (int j = 0; j < 4; ++j) { u32x2 o; o.x = pk(v[q][j][0], v[q][j][1]); o.y = pk(v[q][j][2], v[q][j][3]); ((u32x2*)(P.XB + (size_t)rw * 1024))[lane + 64 * j] = o; }
                    if (lane == 0) P.ss[rw] = sq[q];
                } }
        }
        for (int row = gw; row < 8192; row += NGW) row1024(a.in[8] + (size_t)row * 1024, nullptr, P.MEMB + (size_t)row * 1024, P.ss + SS_MEM + row, lane);
        cvt_rows(a.in[2], P.Ks, 16384, 768, 1024, 1056, gw, NGW, lane);
        cvt_rows(a.in[3], P.Vs, 16384, 768, 1024, 1056, gw, NGW, lane);
        cvt_rows(a.in[4], P.KBs, 4096, 768, 512, 544, gw, NGW, lane);
        cvt_rows(a.in[5], P.VBs, 4096, 768, 512, 544, gw, NGW, lane);
        cvt_rows(a.in[6], P.MKS, 8192, 256, 1, 1, gw, NGW, lane);
        cvt_rows(a.in[7], P.MVS, 8192, 256, 1, 1, gw, NGW, lane);
        for (size_t i = (size_t)blockIdx.x * 512 + tid; i < 12 * SS_STRIDE; i += (size_t)G * 512) P.ss[SS_STRIDE + i] = 0.f;
    }
    grid.sync();

    pg8::StaticOrder so;
    pg8::ProjCtx pc; pc.kind = 0; pc.l = 0; pc.QO = P.QO; pc.Kp = P.Kp; pc.Vp = P.Vp; pc.Ks = P.Ks; pc.Vs = P.Vs; pc.KBp = P.KBp; pc.VBp = P.VBp; pc.KBs = P.KBs; pc.VBs = P.VBs; pc.MKV = P.MKV; pc.out = a.out;
    {
        pg8::Gemm g{P.MEMB, P.W + W_MEM, 8192, 2048, 1024}; so.init(8192, 2048, G, blockIdx.x);
        pg8::EpiProj e; e.ss = P.ss + SS_MEM; e.c = pc; e.c.kind = 3;
        pg8::gemm_phase<pg8::EpiProj, pg8::StaticOrder, true, true>(lds, g, so, e);
    }
#pragma unroll 1
    for (int l = 0; l < 4; ++l) {
        bf16_t* wl = P.W + (size_t)l * W_L;
        float* ss0 = P.ss + (size_t)(3 * l) * SS_STRIDE;
        { SmpEpi se{}; se.mode = 0; se.ss = ss0; se.H = P.HID; sample_gemm(P.XB + (size_t)MP * 1024, wl + W_GU1, 5632, 1024, se); }
        { pg8::Gemm g{P.XB, wl + W_GU1, MP, 5632, 1024}; so.init(MP, 5632, G, blockIdx.x); pg8::EpiGU e{P.HID, ss0};
          pg8::gemm_phase<pg8::EpiGU, pg8::StaticOrder, true, true>(lds, g, so, e); }
        xcd_barrier(xbar);
        { SmpEpi se{}; se.mode = 1; se.XB = P.XB; se.ssn = ss0 + SS_STRIDE; se.sc = 0.5f; sample_gemm(P.HID + (size_t)MP * 2816, wl + W_D1, 1024, 2816, se); }
        { pg8::Gemm g{P.HID, wl + W_D1, MP, 1024, 2816}; so.init(MP, 1024, G, blockIdx.x); pg8::EpiRes e{P.XB, ss0 + SS_STRIDE, 0.5f};
          pg8::gemm_phase<pg8::EpiRes, pg8::StaticOrder, true, true>(lds, g, so, e); }
        xcd_barrier(xbar);
        {
            pg8::EpiProj e; e.ss = ss0 + SS_STRIDE; e.c = pc; e.c.l = l;
            if (l < 2) { e.c.kind = 0; e.c.Ks = P.Ks + (size_t)l * KS_L; e.c.Vs = P.Vs + (size_t)l * KS_L;
                { SmpEpi se{}; se.mode = 2; se.ss = e.ss; se.pc = e.c; sample_gemm(P.XB + (size_t)MP * 1024, P.W + W_INA + (size_t)l * 2621440, 2560, 1024, se); }
                pg8::Gemm g{P.XB, P.W + W_INA + (size_t)l * 2621440, MP, 2560, 1024}; so.init(MP, 2560, G, blockIdx.x);
                pg8::gemm_phase<pg8::EpiProj, pg8::StaticOrder, true, true>(lds, g, so, e); }
            else { e.c.kind = 1;
                { SmpEpi se{}; se.mode = 2; se.ss = e.ss; se.pc = e.c; sample_gemm(P.XB + (size_t)MP * 1024, P.W + W_INB + (size_t)(l - 2) * 1048576, 1024, 1024, se); }
                pg8::Gemm g{P.XB, P.W + W_INB + (size_t)(l - 2) * 1048576, MP, 1024, 1024}; so.init(MP, 1024, G, blockIdx.x);
                pg8::gemm_phase<pg8::EpiProj, pg8::StaticOrder, true, true>(lds, g, so, e); }
        }
        xcd_barrier(xbar);
        attn_phase(P, l, a.in[20], lds);
        xcd_barrier(xbar);
        { SmpEpi se{}; se.mode = 1; se.XB = P.XB; se.ssn = ss0 + 2 * SS_STRIDE; se.sc = 1.0f; sample_gemm(P.QO + (size_t)MP * 1024, P.W + W_OUT + (size_t)l * 1048576, 1024, 1024, se); }
        { pg8::Gemm g{P.QO, P.W + W_OUT + (size_t)l * 1048576, MP, 1024, 1024}; so.init(MP, 1024, G, blockIdx.x); pg8::EpiRes e{P.XB, ss0 + 2 * SS_STRIDE, 1.0f};
          pg8::gemm_phase<pg8::EpiRes, pg8::StaticOrder, true, true>(lds, g, so, e); }
        xcd_barrier(xbar);
        { SmpEpi se{}; se.mode = 0; se.ss = ss0 + 2 * SS_STRIDE; se.H = P.HID; sample_gemm(P.XB + (size_t)MP * 1024, wl + W_GU2, 5632, 1024, se); }
        { pg8::Gemm g{P.XB, wl + W_GU2, MP, 5632, 1024}; so.init(MP, 5632, G, blockIdx.x); pg8::EpiGU e{P.HID, ss0 + 2 * SS_STRIDE};
          pg8::gemm_phase<pg8::EpiGU, pg8::StaticOrder, true, true>(lds, g, so, e); }
        xcd_barrier(xbar);
        { SmpEpi se{}; se.mode = 1; se.XB = P.XB; se.ssn = ss0 + 3 * SS_STRIDE; se.sc = 0.5f; sample_gemm(P.HID + (size_t)MP * 2816, wl + W_D2, 1024, 2816, se); }
        { pg8::Gemm g{P.HID, wl + W_D2, MP, 1024, 2816}; so.init(MP, 1024, G, blockIdx.x); pg8::EpiRes e{P.XB, ss0 + 3 * SS_STRIDE, 0.5f};
          pg8::gemm_phase<pg8::EpiRes, pg8::StaticOrder, true, true>(lds, g, so, e); }
        xcd_barrier(xbar);
        if (l == 1) {
            pg8::EpiProj e; e.ss = ss0 + 3 * SS_STRIDE; e.c = pc; e.c.kind = 2;
            { SmpEpi se{}; se.mode = 2; se.ss = e.ss; se.pc = e.c; sample_gemm(P.XB + (size_t)MP * 1024, P.W + W_KVB, 1536, 1024, se); }
            pg8::Gemm g{P.XB, P.W + W_KVB, MP, 1536, 1024}; so.init(MP, 1536, G, blockIdx.x);
            pg8::gemm_phase<pg8::EpiProj, pg8::StaticOrder, true, true>(lds, g, so, e);
        }
    }
    {
        const int tid = opaque_tid(), lane = tid & 63, wid = __builtin_amdgcn_readfirstlane(tid >> 6), gw = blockIdx.x * 8 + wid;
        const float* ssf = P.ss + 12 * SS_STRIDE; const float* gf = a.in[24];
        f32x4 gg[4];
#pragma unroll
        for (int j = 0; j < 4; ++j) gg[j] = ((const f32x4*)gf)[lane + 64 * j];
        for (int row = gw; row < MT; row += 4 * NGW) {
            u32x2 w[4][4]; float rs[4];
#pragma unroll
            for (int q = 0; q < 4; ++q) { const int rw = row + q * NGW;
                if (rw < MT) { rs[q] = ssf[rw]; const u32x2* xp = (const u32x2*)(P.XB + (size_t)rw * 1024);
#pragma unroll
                    for (int j = 0; j < 4; ++j) w[q][j] = xp[lane + 64 * j]; } }
#pragma unroll
            for (int q = 0; q < 4; ++q) { const int rw = row + q * NGW;
                if (rw < MT) { const float r1 = __builtin_amdgcn_rsqf(rs[q] * (1.0f / 1024.0f) + 1e-6f); f32x4* yp = (f32x4*)(Y + (size_t)rw * 1024);
#pragma unroll
                    for (int j = 0; j < 4; ++j) { f32x4 v;
                        v[0] = __builtin_bit_cast(float, w[q][j].x << 16); v[1] = __builtin_bit_cast(float, w[q][j].x & 0xffff0000u); v[2] = __builtin_bit_cast(float, w[q][j].y << 16); v[3] = __builtin_bit_cast(float, w[q][j].y & 0xffff0000u);
                        yp[lane + 64 * j] = v * r1 * gg[j]; } } }
        }
    }
}
}

extern "C" void kernel_launch(void* const* d_in, const int* in_sizes, int n_in, void* d_out, int out_size, void* d_ws, size_t ws_size, hipStream_t stream) {
    static int grid = 0;
    if (grid == 0) {
        if (n_in != 25 || (size_t)out_size != pg8::O_END || ws_size < mk::WS_END) { fprintf(stderr, "kernel_launch: unexpected shapes: n_in %d out %d ws %zu\n", n_in, out_size, ws_size); grid = -1; return; }
        int dev = 0, cus = 0, per_cu = 0;
        hipGetDevice(&dev); hipDeviceGetAttribute(&cus, hipDeviceAttributeMultiprocessorCount, dev);
        if (hipFuncSetAttribute((const void*)mk::yoco_fwd, hipFuncAttributeMaxDynamicSharedMemorySize, mk::LDS_BYTES) != hipSuccess) { fprintf(stderr, "kernel_launch: hipFuncSetAttribute failed\n"); grid = -1; return; }
        if (hipOccupancyMaxActiveBlocksPerMultiprocessor(&per_cu, (const void*)mk::yoco_fwd, 512, mk::LDS_BYTES) != hipSuccess || per_cu < 1) { fprintf(stderr, "kernel_launch: occupancy query says %d\n", per_cu); per_cu = 1; }
        (void)hipGetLastError();
        grid = cus;
    }
    if (grid < 0) return;
    if (hipMemsetAsync((char*)d_ws + mk::WS_BAR, 0, mk::BAR_BYTES, stream) != hipSuccess) { fprintf(stderr, "kernel_launch: hipMemsetAsync failed\n"); return; }
    mk::Args a{};
    for (int i = 0; i < 25; ++i) a.in[i] = (const float*)d_in[i];
    a.out = (float*)d_out; a.ws = (unsigned char*)d_ws;
    void* args[] = {&a};
    hipError_t e = hipLaunchCooperativeKernel((const void*)mk::yoco_fwd, dim3(grid), dim3(512), args, mk::LDS_BYTES, stream);
    if (e != hipSuccess) fprintf(stderr, "cooperative launch failed: %s (grid %d)\n", hipGetErrorString(e), grid);
}
```

```cpp
#include <hip/hip_runtime.h>
#include <hip/hip_cooperative_groups.h>
#include <cstdio>
#include <cstdint>
namespace cg = cooperative_groups;
namespace pg8 {
#define PG8_LAS __attribute__((address_space(3)))
typedef unsigned short bf16_t;
typedef short bf16x8 __attribute__((ext_vector_type(8)));
typedef float f32x4 __attribute__((ext_vector_type(4)));
typedef unsigned u32x4 __attribute__((ext_vector_type(4)));
constexpr int BM = 256, BK = 64, HALF = 128, HTB = HALF * BK * 2  , STAGE_BYTES = 8 * HTB, NXCD = 8, WGM = 8;

__host__ __device__ __forceinline__ int lds_byte(int r, int c) { const int st = (r >> 4) * 2 + (c >> 5), rr = r & 15, cc = c & 31, ob = rr * 64 + cc * 2; return st * 1024 + (ob ^ (((ob >> 9) & 1) << 5)); }
__host__ __device__ __forceinline__ void stage_rc(int b, int& R, int& C) { const int st = b / 1024, sb = b % 1024, swz = sb ^ (((sb >> 9) & 1) << 5); R = (st >> 1) * 16 + swz / 64; C = (st & 1) * 32 + (swz % 64) / 2; }
__host__ __device__ __forceinline__ int perm32(int rho) { const int n = rho >> 4, i = rho & 15; return 8 * (i >> 2) + 4 * n + (i & 3); }

struct Unit { int pm, pn; };
struct Gemm { const bf16_t* A; const bf16_t* Bt; int M, N, K; };

struct StaticOrder {
    int nM, nN, nwg, G, c;
    __host__ __device__ void init(int M, int N, int G_, int c_) { nM = M / BM; nN = N / BM; nwg = nM * nN; G = G_; c = c_; }
    __host__ __device__ bool next(int i, Unit& u) const {
        const long L = (long)i * G + c; if (L >= nwg) return false;
        int wgid = (int)L; { const int q = nwg / NXCD, r = nwg % NXCD, xcd = wgid % NXCD, off = wgid / NXCD; wgid = (xcd < r ? xcd * (q + 1) : r * (q + 1) + (xcd - r) * q) + off; }
        const int nig = WGM * nN, gid = wgid / nig, fm = gid * WGM, gsz = (nM - fm) < WGM ? (nM - fm) : WGM;
        u.pm = fm + ((wgid % nig) % gsz); u.pn = (wgid % nig) / gsz; return true;
    }
    __device__ __forceinline__ void a_ready(const Unit&) const {}
    __device__ __forceinline__ void done(const Unit&) const {}
};

__device__ __forceinline__ unsigned cvt_pk_bf16(float lo, float hi) { unsigned r; asm volatile("v_cvt_pk_bf16_f32 %0, %1, %2" : "=v"(r) : "v"(lo), "v"(hi)); return r; }

__device__ __forceinline__ u32x4 pack8(const f32x4& a, const f32x4& b) { u32x4 w; w.x = cvt_pk_bf16(a[0], a[1]); w.y = cvt_pk_bf16(a[2], a[3]); w.z = cvt_pk_bf16(b[0], b[1]); w.w = cvt_pk_bf16(b[2], b[3]); return w; }

struct EpiGU {
    static constexpr bool PERM = true, AFTER_DRAIN = false;
    bf16_t* H; const float* ss;
    __device__ __forceinline__ void operator()(const f32x4 (&acc)[2][2][4][2], const Unit& u, int wr, int wc, int fr_, int fq_) const {
        int fr = fr_, fq = fq_; asm volatile("" : "+v"(fr), "+v"(fq));
        bf16_t* Hu = H + (size_t)u.pm * BM * 2816 + u.pn * 128; const float* ssu = ss + u.pm * BM;
        const unsigned rl0 = wr * 64 + fr, cl0 = wc * 32 + 8 * fq;
        float rsv[2][4];
#pragma unroll
        for (int ai = 0; ai < 2; ++ai)
#pragma unroll
            for (int m = 0; m < 4; ++m) rsv[ai][m] = ssu[rl0 + ai * HALF + m * 16];
#pragma unroll
        for (int ai = 0; ai < 2; ++ai)
#pragma unroll
            for (int m = 0; m < 4; ++m) {
                const unsigned rl = rl0 + ai * HALF + m * 16;
                const float rs = __builtin_amdgcn_rsqf(rsv[ai][m] * (1.0f / 1024.0f) + 1e-6f);
                f32x4 h[2]; const float k1 = rs * -1.4426950408889634f, rs2 = rs * rs;
#pragma unroll
                for (int n = 0; n < 2; ++n) {
                    const f32x4 t = acc[ai][0][m][n] * k1, gu = acc[ai][0][m][n] * acc[ai][1][m][n];
                    f32x4 e;
#pragma unroll
                    for (int j = 0; j < 4; ++j) e[j] = __builtin_amdgcn_exp2f(t[j]);
                    e = e + 1.0f;
#pragma unroll
                    for (int j = 0; j < 4; ++j) e[j] = __builtin_amdgcn_rcpf(e[j]);
                    h[n] = gu * (e * rs2);
                }
                *(u32x4*)(Hu + (rl * 2816u + cl0)) = pack8(h[0], h[1]);
            }
    }
};

__device__ __forceinline__ f32x4 unpk_lo(const u32x4& w) { f32x4 r; r[0] = __builtin_bit_cast(float, w.x << 16); r[1] = __builtin_bit_cast(float, w.x & 0xffff0000u); r[2] = __builtin_bit_cast(float, w.y << 16); r[3] = __builtin_bit_cast(float, w.y & 0xffff0000u); return r; }
__device__ __forceinline__ f32x4 unpk_hi(const u32x4& w) { f32x4 r; r[0] = __builtin_bit_cast(float, w.z << 16); r[1] = __builtin_bit_cast(float, w.z & 0xffff0000u); r[2] = __builtin_bit_cast(float, w.w << 16); r[3] = __builtin_bit_cast(float, w.w & 0xffff0000u); return r; }
struct EpiRes {
    static constexpr bool PERM = true, AFTER_DRAIN = false;
    bf16_t* XB; float* ssn; float sc;
    __device__ __forceinline__ void operator()(const f32x4 (&acc)[2][2][4][2], const Unit& u, int wr, int wc, int fr_, int fq_) const {
        int fr = fr_, fq = fq_; asm volatile("" : "+v"(fr), "+v"(fq));
        bf16_t* XBu = XB + (size_t)u.pm * BM * 1024 + u.pn * BM; float* ssu = ssn + u.pm * BM;
        const unsigned rl0 = wr * 64 + fr, cl0 = wc * 32 + 8 * fq;
        u32x4 xin[2][4][2];
#pragma unroll
        for (int ai = 0; ai < 2; ++ai)
#pragma unroll
            for (int m = 0; m < 4; ++m)
#pragma unroll
                for (int bj = 0; bj < 2; ++bj) xin[ai][m][bj] = *(const u32x4*)(XBu + ((rl0 + ai * HALF + m * 16) * 1024u + cl0 + bj * HALF));
#pragma unroll
        for (int ai = 0; ai < 2; ++ai)
#pragma unroll
            for (int m = 0; m < 4; ++m) {
                const unsigned rl = rl0 + ai * HALF + m * 16;
                float part = 0.f;
#pragma unroll
                for (int bj = 0; bj < 2; ++bj) {
                    const unsigned off = rl * 1024u + cl0 + bj * HALF;
                    const u32x4 w = xin[ai][m][bj];
                    f32x4 x0 = unpk_lo(w), x1 = unpk_hi(w);
                    x0 = x0 + acc[ai][bj][m][0] * sc; x1 = x1 + acc[ai][bj][m][1] * sc;
                    *(u32x4*)(XBu + off) = pack8(x0, x1);
                    part += (x0[0] * x0[0] + x0[1] * x0[1]) + (x0[2] * x0[2] + x0[3] * x0[3]) + (x1[0] * x1[0] + x1[1] * x1[1]) + (x1[2] * x1[2] + x1[3] * x1[3]);
                }
                part += __shfl_xor(part, 16); part += __shfl_xor(part, 32);
                if (fq == 0) unsafeAtomicAdd(ssu + rl, part);
            }
    }
};

struct Route { bf16_t* b; float* f; int ldb, ldf, grp; };
struct ProjCtx {
    int kind, l;
    bf16_t *QO, *Kp, *Vp, *Ks, *Vs, *KBp, *VBp, *KBs, *VBs, *MKV;
    float* out;
};
constexpr size_t O_YS = 67108864, O_AKP = 67371008, O_AVP = 168034304, O_BKP = 268697600, O_BVP = 281280512, O_MKP = 293863424, O_MVP = 302252032,
                 O_AKS = 310640640, O_AVS = 311033856, O_BKS = 311427072, O_BVS = 311623680, O_END = 311820288;
__device__ __forceinline__ Route route_unit(const ProjCtx& c, const Unit& u) {
    Route r; r.b = nullptr; r.f = nullptr; r.ldb = 1024; r.ldf = 768; r.grp = 0;
    const int pm = u.pm, pn = u.pn; const bool smp = (pm == 256);
    if (c.kind == 0) {
        if (pn < 3 || pn == 9) { r.b = c.QO + (size_t)pm * 256 * 1024 + (pn == 9 ? 768 : pn * 256); r.ldb = 1024; }
        else { const bool isv = pn >= 6; const int ck = (pn - (isv ? 6 : 3)) * 256; r.ldb = 768; r.ldf = 768;
            if (!smp) { r.b = (isv ? c.Vp : c.Kp) + (size_t)pm * 256 * 768 + ck; r.f = c.out + (isv ? O_AVP : O_AKP) + ((size_t)c.l * 65536 + (size_t)pm * 256) * 768 + ck; }
            else { r.b = (isv ? c.Vs : c.Ks) + (size_t)1024 * 768 + ck; r.grp = 1056; r.f = c.out + (isv ? O_AVS : O_AKS) + (size_t)c.l * 256 * 768 + ck; } }
    } else if (c.kind == 1) {
        r.b = c.QO + (size_t)pm * 256 * 1024 + pn * 256; r.ldb = 1024;
    } else if (c.kind == 2) {
        const bool isv = pn >= 3; const int ck = (pn - (isv ? 3 : 0)) * 256; r.ldb = 768; r.ldf = 768;
        if (!smp) { r.b = (isv ? c.VBp : c.KBp) + (size_t)pm * 256 * 768 + ck;
            if ((pm & 7) >= 6) r.f = c.out + (isv ? O_BVP : O_BKP) + ((size_t)(pm >> 3) * 512 + (size_t)((pm & 7) - 6) * 256) * 768 + ck; }
        else { r.b = (isv ? c.VBs : c.KBs) + (size_t)512 * 768 + ck; r.grp = 544; r.f = c.out + (isv ? O_BVS : O_BKS) + ck; }
    } else {
        const int l = pn >> 1, kv = pn & 1;
        r.b = c.MKV + (size_t)pm * 256 * 2048 + pn * 256; r.ldb = 2048;
        r.f = c.out + (kv ? O_MVP : O_MKP) + ((size_t)(l * 32 + pm) * 256) * 256; r.ldf = 256;
    }
    return r;
}
struct EpiProj {
    static constexpr bool PERM = true, AFTER_DRAIN = false;
    const float* ss; ProjCtx c;
    __device__ __forceinline__ void operator()(const f32x4 (&acc)[2][2][4][2], const Unit& u, int wr, int wc, int fr_, int fq_) const {
        int fr = fr_, fq = fq_; asm volatile("" : "+v"(fr), "+v"(fq));
        const Route rt = route_unit(c, u);
        const unsigned rl0 = wr * 64 + fr, cl0 = wc * 32 + 8 * fq; const float* ssu = ss + u.pm * BM;
        float rsv[2][4];
#pragma unroll
        for (int ai = 0; ai < 2; ++ai)
#pragma unroll
            for (int m = 0; m < 4; ++m) rsv[ai][m] = ssu[rl0 + ai * HALF + m * 16];
#pragma unroll
        for (int ai = 0; ai < 2; ++ai)
#pragma unroll
            for (int m = 0; m < 4; ++m) {
                const unsigned rl = rl0 + ai * HALF + m * 16;
                const float rs = __builtin_amdgcn_rsqf(rsv[ai][m] * (1.0f / 1024.0f) + 1e-6f);
                const unsigned rb = rt.grp ? (rl >> 5) * (unsigned)rt.grp + (rl & 31u) : rl;
#pragma unroll
                for (int bj = 0; bj < 2; ++bj) {
                    const f32x4 v0 = acc[ai][bj][m][0] * rs, v1 = acc[ai][bj][m][1] * rs; const unsigned cl = cl0 + bj * HALF;
                    if (rt.b) *(u32x4*)(rt.b + (rb * (unsigned)rt.ldb + cl)) = pack8(v0, v1);
                    if (rt.f) { float* fp = rt.f + (rl * (unsigned)rt.ldf + cl); *(f32x4*)fp = v0; *(f32x4*)(fp + 4) = v1; }
                }
            }
    }
};

template <class Epi, class Sched, bool ALIGN_EPI = false, bool SP2 = false>
__device__ __forceinline__ void gemm_phase(PG8_LAS unsigned char* lds, const Gemm g, const Sched& S, const Epi& E) {
    int tid_ = threadIdx.x; asm volatile("" : "+v"(tid_));
    const int tid = tid_, wid = __builtin_amdgcn_readfirstlane(tid >> 6), lane = tid & 63, wr = wid >> 2, wc = wid & 3, fr = lane & 15, fq = lane >> 4;
    const int K = g.K, nt = K / BK;
    unsigned voffA[2], voffB[2];
#pragma unroll
    for (int i = 0; i < 2; ++i) { int R, C; stage_rc(tid * 16 + i * 8192, R, C); const int Rb = Epi::PERM ? ((R & ~31) + perm32(R & 31)) : R;
        voffA[i] = (unsigned)(R * K + C) * 2u; voffB[i] = (unsigned)(Rb * K + C) * 2u; }
    const size_t kstep = (size_t)(BK * 2);
    const size_t hstep = (size_t)HALF * K * 2;
    const size_t tstep = 2 * hstep;
    const unsigned ldsw = (unsigned)wid * 1024u;
    const int aoff = lds_byte(wr * 64 + fr, fq * 8), boff = lds_byte(wc * 32 + fr, fq * 8);
#define PG8_SA(b, h) (((b) * 2 + (h)) * HTB)
#define PG8_SB(b, h) ((4 + (b) * 2 + (h)) * HTB)
#define PG8_STAGE(bufoff, gbase, voff) do { _Pragma("unroll") for (int _i = 0; _i < 2; ++_i) \
        __builtin_amdgcn_global_load_lds((const unsigned*)((const char*)(gbase) + (voff)[_i]), (PG8_LAS unsigned*)(lds + (bufoff) + ldsw + _i * 8192), 16, 0, 0); } while (0)
#define PG8_LDA(dst, b, h) do { _Pragma("unroll") for (int m = 0; m < 4; ++m) _Pragma("unroll") for (int k = 0; k < 2; ++k) dst[m][k] = *(const PG8_LAS bf16x8*)(lds + PG8_SA(b, h) + aoff + m * 2048 + k * 1024); } while (0)
#define PG8_LDB(dst, b, h) do { _Pragma("unroll") for (int n = 0; n < 2; ++n) _Pragma("unroll") for (int k = 0; k < 2; ++k) dst[n][k] = *(const PG8_LAS bf16x8*)(lds + PG8_SB(b, h) + boff + n * 2048 + k * 1024); } while (0)
#define PG8_MMA(ai, bj, At, Bt) do { __builtin_amdgcn_s_setprio(1); _Pragma("unroll") for (int m = 0; m < 4; ++m) _Pragma("unroll") for (int n = 0; n < 2; ++n) _Pragma("unroll") for (int k = 0; k < 2; ++k) \
        acc[ai][bj][m][n] = __builtin_amdgcn_mfma_f32_16x16x32_bf16(Bt[n][k], At[m][k], acc[ai][bj][m][n], 0, 0, 0); __builtin_amdgcn_s_setprio(0); } while (0)
#define PG8_WAIT_V(n) asm volatile("s_waitcnt vmcnt(" #n ")" ::: "memory")
#define PG8_WAIT_L(n) asm volatile("s_waitcnt lgkmcnt(" #n ")" ::: "memory")
#define PG8_BAR __builtin_amdgcn_s_barrier()
#define PG8_SCHED __builtin_amdgcn_sched_barrier(0)
    Unit cur, nxt; int ui = 0;
    if (!S.next(0, cur)) return;
    f32x4 acc[2][2][4][2];
#pragma unroll
    for (int a = 0; a < 2; ++a)
#pragma unroll
        for (int b = 0; b < 2; ++b)
#pragma unroll
            for (int m = 0; m < 4; ++m)
#pragma unroll
                for (int n = 0; n < 2; ++n) acc[a][b][m][n] = (f32x4){0.f, 0.f, 0.f, 0.f};
    bf16x8 At[4][2], B0[2][2], B1[2][2];
    const char* cA = (const char*)g.A + (size_t)cur.pm * tstep; const char* cB = (const char*)g.Bt + (size_t)cur.pn * tstep;
    S.a_ready(cur);
    if constexpr (SP2) {
        PG8_STAGE(PG8_SB(0, 0), cB, voffB); PG8_STAGE(PG8_SB(0, 1), cB + hstep, voffB); PG8_STAGE(PG8_SA(0, 0), cA, voffA); PG8_STAGE(PG8_SA(0, 1), cA + hstep, voffA);
        if (wr == 1) PG8_BAR;
        PG8_WAIT_V(2); PG8_BAR;
        PG8_STAGE(PG8_SB(1, 0), cB + kstep, voffB); PG8_STAGE(PG8_SA(1, 0), cA + kstep, voffA); PG8_STAGE(PG8_SB(1, 1), cB + hstep + kstep, voffB);
        PG8_WAIT_V(6); PG8_BAR;
    } else {
        PG8_STAGE(PG8_SB(0, 0), cB, voffB); PG8_STAGE(PG8_SA(0, 0), cA, voffA); PG8_STAGE(PG8_SB(0, 1), cB + hstep, voffB); PG8_STAGE(PG8_SA(0, 1), cA + hstep, voffA);
        if (wr == 1) PG8_BAR;
        PG8_WAIT_V(4); PG8_BAR;
        PG8_STAGE(PG8_SB(1, 0), cB + kstep, voffB); PG8_STAGE(PG8_SA(1, 0), cA + kstep, voffA); PG8_STAGE(PG8_SB(1, 1), cB + hstep + kstep, voffB);
        PG8_WAIT_V(6); PG8_BAR;
    }
    for (;;) {
        const bool has_next = S.next(ui + 1, nxt);
        const char* nA = has_next ? (const char*)g.A + (size_t)nxt.pm * tstep : cA; const char* nB = has_next ? (const char*)g.Bt + (size_t)nxt.pn * tstep : cB;
        for (int t = 0; t < nt; t += 2) {
            const bool last = (t == nt - 2);
            const char* a1 = cA + (size_t)(t + 1) * kstep;
            const char* a2 = last ? nA : cA + (size_t)(t + 2) * kstep; const char* b2 = last ? nB : cB + (size_t)(t + 2) * kstep;
            const char* a3 = a2 + kstep; const char* b3 = b2 + kstep;
            if (last && has_next) S.a_ready(nxt);
            if constexpr (SP2) {
            PG8_LDB(B0, 0, 0); PG8_LDB(B1, 0, 1); PG8_SCHED; PG8_LDA(At, 0, 0); PG8_STAGE(PG8_SA(1, 1), a1 + hstep, voffA);
            PG8_WAIT_V(8); PG8_WAIT_L(0); PG8_BAR; PG8_MMA(0, 0, At, B0); PG8_MMA(0, 1, At, B1); PG8_BAR; PG8_SCHED;
            PG8_LDA(At, 0, 1); PG8_STAGE(PG8_SB(0, 0), b2, voffB); PG8_STAGE(PG8_SB(0, 1), b2 + hstep, voffB); PG8_STAGE(PG8_SA(0, 0), a2, voffA);
            PG8_WAIT_V(8); PG8_WAIT_L(0); PG8_BAR; PG8_MMA(1, 0, At, B0); PG8_MMA(1, 1, At, B1); PG8_BAR; PG8_SCHED;
            PG8_LDB(B0, 1, 0); PG8_LDB(B1, 1, 1); PG8_SCHED; PG8_LDA(At, 1, 0); PG8_STAGE(PG8_SA(0, 1), a2 + hstep, voffA);
            PG8_WAIT_V(8); PG8_WAIT_L(0); PG8_BAR; PG8_MMA(0, 0, At, B0); PG8_MMA(0, 1, At, B1); PG8_BAR; PG8_SCHED;
            PG8_LDA(At, 1, 1); PG8_STAGE(PG8_SB(1, 0), b3, voffB); PG8_STAGE(PG8_SB(1, 1), b3 + hstep, voffB); PG8_STAGE(PG8_SA(1, 0), a3, voffA);
            PG8_WAIT_V(8); PG8_WAIT_L(0); PG8_BAR; PG8_MMA(1, 0, At, B0); PG8_MMA(1, 1, At, B1); PG8_BAR; PG8_SCHED;
            } else {
            PG8_LDB(B0, 0, 0); PG8_SCHED; PG8_LDA(At, 0, 0); PG8_STAGE(PG8_SA(1, 1), a1 + hstep, voffA);
            PG8_WAIT_L(8); PG8_BAR; PG8_WAIT_L(0); PG8_MMA(0, 0, At, B0); PG8_BAR; PG8_SCHED;
            PG8_LDB(B1, 0, 1); PG8_STAGE(PG8_SB(0, 0), b2, voffB);
            PG8_BAR; PG8_WAIT_L(0); PG8_MMA(0, 1, At, B1); PG8_BAR;
            PG8_LDA(At, 0, 1); PG8_STAGE(PG8_SA(0, 0), a2, voffA);
            PG8_BAR; PG8_WAIT_L(0); PG8_MMA(1, 0, At, B0); PG8_BAR; PG8_SCHED;
            PG8_STAGE(PG8_SB(0, 1), b2 + hstep, voffB);
            PG8_WAIT_V(6); PG8_BAR; PG8_MMA(1, 1, At, B1); PG8_BAR;
            PG8_LDB(B0, 1, 0); PG8_SCHED; PG8_LDA(At, 1, 0); PG8_STAGE(PG8_SA(0, 1), a2 + hstep, voffA);
            PG8_WAIT_L(8); PG8_BAR; PG8_WAIT_L(0); PG8_MMA(0, 0, At, B0); PG8_BAR; PG8_SCHED;
            PG8_LDB(B1, 1, 1); PG8_STAGE(PG8_SB(1, 0), b3, voffB);
            PG8_BAR; PG8_WAIT_L(0); PG8_MMA(0, 1, At, B1); PG8_BAR;
            PG8_LDA(At, 1, 1); PG8_STAGE(PG8_SA(1, 0), a3, voffA);
            PG8_BAR; PG8_WAIT_L(0); PG8_MMA(1, 0, At, B0); PG8_BAR; PG8_SCHED;
            PG8_STAGE(PG8_SB(1, 1), b3 + hstep, voffB);
            PG8_WAIT_V(6); PG8_BAR; PG8_MMA(1, 1, At, B1); PG8_BAR;
            }
        }
        if constexpr (ALIGN_EPI) { if (wr == 0) PG8_BAR; }
        if constexpr (!Epi::AFTER_DRAIN) { E(acc, cur, wr, wc, fr, fq); S.done(cur); }
        if (!has_next) break;
#pragma unroll
        for (int a = 0; a < 2; ++a)
#pragma unroll
            for (int b = 0; b < 2; ++b)
#pragma unroll
                for (int m = 0; m < 4; ++m)
#pragma unroll
                    for (int n = 0; n < 2; ++n) acc[a][b][m][n] = (f32x4){0.f, 0.f, 0.f, 0.f};
        cur = nxt; cA = nA; cB = nB; ++ui;
        if constexpr (ALIGN_EPI) { if (wr == 1) PG8_BAR; }
    }
    PG8_WAIT_V(0);
    if constexpr (!ALIGN_EPI) { if (wr == 0) PG8_BAR; }
    PG8_BAR;
    if constexpr (Epi::AFTER_DRAIN) { E.fused(acc, cur, wr, wc, fr, fq, lds, wid, lane); S.done(cur); }
#undef PG8_SA
#undef PG8_SB
#undef PG8_STAGE
#undef PG8_LDA
#undef PG8_LDB
#undef PG8_MMA
#undef PG8_WAIT_V
#undef PG8_WAIT_L
#undef PG8_BAR
#undef PG8_SCHED
}
}

namespace mk {
using pg8::bf16_t; using pg8::bf16x8; using pg8::f32x4; using pg8::u32x4;
typedef float f32x16 __attribute__((ext_vector_type(16)));
typedef short s16x4 __attribute__((ext_vector_type(4)));
typedef short v4i16_t __attribute__((ext_vector_type(4)));
typedef unsigned u32x2 __attribute__((ext_vector_type(2)));
typedef float f32x2_t __attribute__((ext_vector_type(2)));
typedef __bf16 bf16x2_t __attribute__((ext_vector_type(2)));
#define LAS __attribute__((address_space(3)))

constexpr int MP = 65536, MT = 65792;
constexpr size_t MiB = 1u << 20;
constexpr size_t WS_SS = 0, WS_W = 4 * MiB, WS_XB = 166 * MiB, WS_UN = 295 * MiB, WS_QO = WS_UN, WS_KP = 424 * MiB, WS_VP = 520 * MiB, WS_KBP = 649 * MiB, WS_VBP = 745 * MiB,
                 WS_MEMB = WS_KBP, WS_KS = 841 * MiB, WS_VS = 866 * MiB, WS_KBS = 891 * MiB, WS_VBS = 898 * MiB, WS_MKV = 905 * MiB, WS_MKS = 937 * MiB, WS_MVS = 941 * MiB, WS_END = 945 * MiB;
constexpr size_t SS_STRIDE = 65792, SS_MEM = 13 * SS_STRIDE;
constexpr size_t WS_BAR = 4 * MiB - 65536, BAR_BYTES = 16384;
static_assert((SS_MEM + 8192 + 65792) * 4 <= WS_BAR, "barrier words clear of the ss rows");
constexpr size_t W_L = 17301504, W_GU1 = 0, W_D1 = 5767168, W_GU2 = 8650752, W_D2 = 14417920;
constexpr size_t W_INA = 69206016, W_INB = 74448896, W_OUT = 76546048, W_MEM = 80740352, W_KVB = 82837504, W_END = 84410368;
static_assert(WS_W + W_END * 2 <= WS_XB && WS_XB + (size_t)MT * 1024 * 2 <= WS_UN && WS_UN + (size_t)MT * 2816 * 2 <= WS_KBP && WS_QO + (size_t)MT * 1024 * 2 <= WS_KP, "ws map");
constexpr size_t KS_L = (size_t)8 * 1056 * 768;
constexpr int LDS_BYTES = 147456;
constexpr float LOG2E = 1.4426950408889634f;

struct Args { const float* in[25]; float* out; unsigned char* ws; };

__device__ __forceinline__ unsigned pk(float lo, float hi) { f32x2_t v = {lo, hi}; bf16x2_t b = __builtin_convertvector(v, bf16x2_t); return __builtin_bit_cast(unsigned, b); }
__device__ __forceinline__ int opaque_tid() { int t = threadIdx.x; asm volatile("" : "+v"(t)); return t; }
__device__ __forceinline__ float wave_sum(float v) {
#pragma unroll
    for (int o = 1; o < 64; o <<= 1) v += __shfl_xor(v, o);
    return v;
}

__device__ __forceinline__ void conv_item(const float* __restrict__ W, int K, int N, bf16_t* WT, int rowoff, const float* __restrict__ g, bool gumap, LAS float* scr, int item, int lane) {
    const int nblk = N / 32, kb = item / nblk, nb = item - kb * nblk, k0 = 64 * kb, n0 = 32 * nb;
    float v[32];
#pragma unroll
    for (int i = 0; i < 32; ++i) v[i] = W[(size_t)(k0 + 2 * i + (lane >> 5)) * N + n0 + (lane & 31)];
    if (g) {
#pragma unroll
        for (int i = 0; i < 32; ++i) v[i] *= g[k0 + 2 * i + (lane >> 5)];
    }
#pragma unroll
    for (int i = 0; i < 32; ++i) scr[(2 * i + (lane >> 5)) * 33 + (lane & 31)] = v[i];
    asm volatile("s_waitcnt lgkmcnt(0)" ::: "memory");
    const int c = lane & 7;
#pragma unroll
    for (int j = 0; j < 4; ++j) {
        const int n = (lane >> 3) + 8 * j; const LAS float* sp = scr + (8 * c) * 33 + n;
        u32x4 o; o.x = pk(sp[0], sp[33]); o.y = pk(sp[66], sp[99]); o.z = pk(sp[132], sp[165]); o.w = pk(sp[198], sp[231]);
        const int nn = n0 + n; int drow = nn;
        if (gumap) { const int half = nn >= 2816 ? 1 : 0, jn = nn - half * 2816; drow = (jn >> 7) * 256 + half * 128 + (jn & 127); }
        *(u32x4*)(WT + (size_t)(rowoff + drow) * K + k0 + 8 * c) = o;
    }
    asm volatile("s_waitcnt lgkmcnt(0)" ::: "memory");
}
__device__ __forceinline__ void conv_w(const float* __restrict__ src, int K, int N, bf16_t* dst, int rowoff, const float* __restrict__ g, bool gumap, LAS float* scr, int gw, int NGW, int lane, int& base) {
    const int nitems = (K / 64) * (N / 32);
    int first = gw - base; if (first < 0) first += NGW;
    for (int it = first; it < nitems; it += NGW) conv_item(src, K, N, dst, rowoff, g, gumap, scr, it, lane);
    base = (base + nitems) % NGW;
}
__device__ __forceinline__ void row1024(const float* src, float* ycopy, bf16_t* xb, float* ssq, int lane) {
    f32x4 v[4]; float s = 0.f;
#pragma unroll
    for (int j = 0; j < 4; ++j) { v[j] = ((const f32x4*)src)[lane + 64 * j]; s += (v[j][0] * v[j][0] + v[j][1] * v[j][1]) + (v[j][2] * v[j][2] + v[j][3] * v[j][3]); }
    s = wave_sum(s);
#pragma unroll
    for (int j = 0; j < 4; ++j) {
        if (ycopy) ((f32x4*)ycopy)[lane + 64 * j] = v[j];
        u32x2 o; o.x = pk(v[j][0], v[j][1]); o.y = pk(v[j][2], v[j][3]); ((u32x2*)xb)[lane + 64 * j] = o;
    }
    if (lane == 0) *ssq = s;
}
__device__ __forceinline__ void cvt_rows(const float* src, bf16_t* dst, int nrows, int rowlen, int srg, int drg, int gw, int NGW, int lane) {
    const int nc = rowlen >> 8;
    for (int row = gw; row < nrows; row += 4 * NGW) {
        f32x4 v[4][3];
#pragma unroll
        for (int q = 0; q < 4; ++q) { const int rw = row + q * NGW;
            if (rw < nrows) {
#pragma unroll
                for (int c = 0; c < 3; ++c) if (c < nc) v[q][c] = *(const f32x4*)(src + (size_t)rw * rowlen + c * 256 + 4 * lane); } }
#pragma unroll
        for (int q = 0; q < 4; ++q) { const int rw = row + q * NGW;
            if (rw < nrows) { const int g = rw / srg, t = rw - g * srg; const size_t drow = (size_t)g * drg + t;
#pragma unroll
                for (int c = 0; c < 3; ++c) if (c < nc) { u32x2 o; o.x = pk(v[q][c][0], v[q][c][1]); o.y = pk(v[q][c][2], v[q][c][3]); *(u32x2*)(dst + drow * rowlen + c * 256 + 4 * lane) = o; } } }
    }
}

__device__ __forceinline__ s16x4 vtr(const LAS unsigned char* p) { return __builtin_bit_cast(s16x4, __builtin_amdgcn_ds_read_tr16_b64_v4i16((LAS v4i16_t*)p)); }
#define MFMA32(a, b, c) __builtin_amdgcn_mfma_f32_32x32x16_bf16((a), (b), (c), 0, 0, 0)

struct AttnState { f32x16 o0, o1; float carry, mrun, lsum; };
template <int MODE>
__device__ __forceinline__ void attn_tile(AttnState& S, const bf16x8 (&qf)[4], const bf16x8 (&kf)[4], const u32x4 (&vr)[4], int k0i, int qpos0, int kpos0,
                                          LAS unsigned char* vwp, const LAS unsigned char* trp, const LAS float* biasT, int r, int h) {
    const float SC = 0.125f * LOG2E;
    f32x16 st;
#pragma unroll
    for (int i = 0; i < 16; ++i) st[i] = 0.f;
#pragma unroll
    for (int s = 0; s < 4; ++s) st = MFMA32(kf[s], qf[s], st);
#pragma unroll
    for (int i = 0; i < 4; ++i) *(LAS u32x4*)(vwp + i * 8 * 144) = vr[i];
    const int dlim = (qpos0 + r) - (kpos0 + k0i) - 4 * h;
    float p[16];
    if constexpr (MODE == 0) {
        float z2[16], lk[16];
#pragma unroll
        for (int i = 0; i < 16; ++i) {
            const int ci = (i & 3) + 8 * (i >> 2);
            z2[i] = st[i] * SC;
            const float t = __builtin_amdgcn_exp2f(-__builtin_fabsf(z2[i]));
            const float sp = __builtin_fmaxf(z2[i], 0.f) + __builtin_amdgcn_logf(1.0f + t);
            lk[i] = (ci < dlim) ? -sp : 0.f;
        }
        float G[4], GP[4];
#pragma unroll
        for (int c = 0; c < 4; ++c) { G[c] = (lk[4 * c] + lk[4 * c + 1]) + (lk[4 * c + 2] + lk[4 * c + 3]); GP[c] = __shfl_xor(G[c], 32); }
        float OS[4], PSE[4], PSI[4];
        OS[3] = 0.f; OS[2] = G[3]; OS[1] = OS[2] + G[2]; OS[0] = OS[1] + G[1];
        PSE[3] = 0.f; PSE[2] = GP[3]; PSE[1] = PSE[2] + GP[2]; PSE[0] = PSE[1] + GP[1];
#pragma unroll
        for (int c = 0; c < 4; ++c) PSI[c] = PSE[c] + GP[c];
#pragma unroll
        for (int c = 0; c < 4; ++c) {
            float aft = S.carry + OS[c] + (h == 0 ? PSI[c] : PSE[c]);
#pragma unroll
            for (int jj = 3; jj >= 0; --jj) {
                const int i = 4 * c + jj; const int ci = (i & 3) + 8 * (i >> 2);
                const float w = __builtin_amdgcn_exp2f(z2[i] + lk[i] + aft);
                p[i] = (ci < dlim) ? w : 0.f;
                aft += lk[i];
            }
        }
        S.carry += (OS[0] + G[0]) + PSI[0];
    } else {
        float s2[16]; float mt = -__builtin_inff();
        const bool farb = (MODE == 1) && ((qpos0 - (kpos0 + k0i) - 31) >= 128);
        const float bfar = (MODE == 1) ? biasT[256] : 0.f;
#pragma unroll
        for (int i = 0; i < 16; ++i) {
            s2[i] = st[i] * SC;
            if constexpr (MODE == 1) {
                if (farb) s2[i] += bfar;
                else { const int ci = (i & 3) + 8 * (i >> 2); int idx = dlim - ci + 128; idx = idx < 0 ? 0 : (idx > 256 ? 256 : idx); s2[i] += biasT[idx]; }
            }
            mt = __builtin_fmaxf(mt, s2[i]);
        }
        mt = __builtin_fmaxf(mt, __shfl_xor(mt, 32));
        const float mnew = __builtin_fmaxf(S.mrun, mt);
        const float alpha = __builtin_amdgcn_exp2f(S.mrun - mnew);
        float ps = 0.f;
#pragma unroll
        for (int i = 0; i < 16; ++i) { p[i] = __builtin_amdgcn_exp2f(s2[i] - mnew); ps += p[i]; }
        S.lsum = S.lsum * alpha + ps; S.mrun = mnew;
#pragma unroll
        for (int i = 0; i < 16; ++i) { S.o0[i] *= alpha; S.o1[i] *= alpha; }
    }
    bf16x8 pb[2], va[2][2];
#pragma unroll
    for (int s2i = 0; s2i < 2; ++s2i) {
        u32x4 pw; pw.x = pk(p[8 * s2i], p[8 * s2i + 1]); pw.y = pk(p[8 * s2i + 2], p[8 * s2i + 3]); pw.z = pk(p[8 * s2i + 4], p[8 * s2i + 5]); pw.w = pk(p[8 * s2i + 6], p[8 * s2i + 7]);
        pb[s2i] = __builtin_bit_cast(bf16x8, pw);
#pragma unroll
        for (int blk = 0; blk < 2; ++blk) {
            const s16x4 lo = vtr(trp + s2i * 2304 + blk * 64), hi = vtr(trp + s2i * 2304 + 1152 + blk * 64);
            va[s2i][blk] = __builtin_shufflevector(lo, hi, 0, 1, 2, 3, 4, 5, 6, 7);
        }
    }
#pragma unroll
    for (int s2i = 0; s2i < 2; ++s2i) { S.o0 = MFMA32(va[s2i][0], pb[s2i], S.o0); S.o1 = MFMA32(va[s2i][1], pb[s2i], S.o1); }
}

template <int MODE>
__device__ __forceinline__ void attn_unit(const bf16_t* Q, const bf16_t* K, const bf16_t* V, bf16_t* O, int kp, int kt_lo, int kt_hi, int qpos0, int kpos0,
                                          LAS unsigned char* vl, const LAS float* biasT, int lane) {
    const int r = lane & 31, h = lane >> 5;
    bf16x8 qf[4];
#pragma unroll
    for (int s = 0; s < 4; ++s) qf[s] = *(const bf16x8*)(Q + (unsigned)(r * 1024 + 16 * s + 8 * h));
    AttnState S;
#pragma unroll
    for (int i = 0; i < 16; ++i) { S.o0[i] = 0.f; S.o1[i] = 0.f; }
    S.carry = 0.f; S.mrun = -__builtin_inff(); S.lsum = 0.f;
    const int nt = kt_hi - kt_lo + 1;
    const int vkey = lane >> 3, vseg = lane & 7;
    const int c16 = (lane >> 4) & 1, q4 = (lane & 15) >> 2, p4 = lane & 3;
    const LAS unsigned char* trp = vl + (4 * h + q4) * 144 + 32 * c16 + 8 * p4;
    LAS unsigned char* vwp = vl + vkey * 144 + vseg * 16;
    const unsigned koff = (unsigned)(r * kp + 8 * h), voff = (unsigned)(vkey * kp + vseg * 8), kp8 = (unsigned)(8 * kp);
    const int step = (MODE == 0) ? -1 : 1;
    int kt = (MODE == 0) ? kt_hi : kt_lo;
    bf16x8 kA[4], kB[4]; u32x4 vA[4], vB[4];
#define ATT_LOAD(kk, vv, ktile) do { const int _kt = (ktile) < kt_lo ? kt_lo : ((ktile) > kt_hi ? kt_hi : (ktile)); \
        const bf16_t* Kt = K + (size_t)_kt * 32 * kp; const bf16_t* Vt = V + (size_t)_kt * 32 * kp; \
        _Pragma("unroll") for (int s = 0; s < 4; ++s) kk[s] = *(const bf16x8*)(Kt + (koff + 16 * s)); \
        _Pragma("unroll") for (int i = 0; i < 4; ++i) vv[i] = *(const u32x4*)(Vt + (voff + i * kp8)); } while (0)
#define ATT_DONE() (MODE == 0 && __builtin_amdgcn_ballot_w64(S.carry > -150.0f) == 0ull)
    ATT_LOAD(kA, vA, kt);
    int it = 0;
    for (; it + 1 < nt; it += 2) {
        ATT_LOAD(kB, vB, kt + step);
        attn_tile<MODE>(S, qf, kA, vA, kt * 32, qpos0, kpos0, vwp, trp, biasT, r, h);
        if (ATT_DONE()) { it = nt; break; }
        ATT_LOAD(kA, vA, kt + 2 * step);
        attn_tile<MODE>(S, qf, kB, vB, (kt + step) * 32, qpos0, kpos0, vwp, trp, biasT, r, h);
        kt += 2 * step;
        if (ATT_DONE()) { it = nt; break; }
    }
    if (it < nt) attn_tile<MODE>(S, qf, kA, vA, kt * 32, qpos0, kpos0, vwp, trp, biasT, r, h);
#undef ATT_LOAD
#undef ATT_DONE
    float inv = 1.0f;
    if constexpr (MODE != 0) { const float l = S.lsum + __shfl_xor(S.lsum, 32); inv = 1.0f / l; }
#pragma unroll
    for (int c = 0; c < 4; ++c) {
        u32x2 a, b;
        a.x = pk(S.o0[4 * c] * inv, S.o0[4 * c + 1] * inv); a.y = pk(S.o0[4 * c + 2] * inv, S.o0[4 * c + 3] * inv);
        b.x = pk(S.o1[4 * c] * inv, S.o1[4 * c + 1] * inv); b.y = pk(S.o1[4 * c + 2] * inv, S.o1[4 * c + 3] * inv);
        *(u32x2*)(O + (unsigned)(r * 1024 + 8 * c + 4 * h)) = a;
        *(u32x2*)(O + (unsigned)(r * 1024 + 32 + 8 * c + 4 * h)) = b;
    }
}

struct SmpEpi { int mode; const float* ss; bf16_t* H; bf16_t* XB; float* ssn; float sc; pg8::ProjCtx pc; };
__device__ __forceinline__ void sample_gemm(const bf16_t* A, const bf16_t* Wt, int N, int K, const SmpEpi& E) {
    const int tid = opaque_tid(), lane = tid & 63, wid = __builtin_amdgcn_readfirstlane(tid >> 6);
    const int r = lane & 31, h = lane >> 5;
    const int gwm = wid * gridDim.x + blockIdx.x, NGW = gridDim.x * 8;
    const int ncb = (E.mode == 0) ? 88 : N / 64, nunits = 8 * ncb, nch = K / 32;
    const unsigned loff = (unsigned)(r * K + 16 * h);
    for (int wu = gwm; wu < nunits; wu += NGW) {
        const int rb = wu & 7, cb = wu >> 3;
        int w0, w1;
        if (E.mode == 0) { const int hc0 = 32 * cb; w0 = 256 * (hc0 >> 7) + (hc0 & 127); w1 = w0 + 128; } else { w0 = 64 * cb; w1 = w0 + 32; }
        const bf16_t* pa = A + (size_t)(rb * 32) * K; const bf16_t* pw0 = Wt + (size_t)w0 * K; const bf16_t* pw1 = Wt + (size_t)w1 * K;
        f32x16 c0, c1;
#pragma unroll
        for (int i = 0; i < 16; ++i) { c0[i] = 0.f; c1[i] = 0.f; }
        constexpr int D = 4;
        bf16x8 xa[D][2], wa[D][2], wb[D][2];
#pragma unroll
        for (int d = 0; d < D; ++d) {
            const unsigned o = loff + d * 32;
            xa[d][0] = *(const bf16x8*)(pa + o); xa[d][1] = *(const bf16x8*)(pa + o + 8);
            wa[d][0] = *(const bf16x8*)(pw0 + o); wa[d][1] = *(const bf16x8*)(pw0 + o + 8);
            wb[d][0] = *(const bf16x8*)(pw1 + o); wb[d][1] = *(const bf16x8*)(pw1 + o + 8);
        }
#pragma unroll 1
        for (int ch = 0; ch < nch; ch += D) {
#pragma unroll
            for (int d = 0; d < D; ++d) {
                c0 = MFMA32(wa[d][0], xa[d][0], c0); c1 = MFMA32(wb[d][0], xa[d][0], c1);
                c0 = MFMA32(wa[d][1], xa[d][1], c0); c1 = MFMA32(wb[d][1], xa[d][1], c1);
                const int nx = ch + d + D;
                if (nx < nch) {
                    const unsigned o = loff + nx * 32;
                    xa[d][0] = *(const bf16x8*)(pa + o); xa[d][1] = *(const bf16x8*)(pa + o + 8);
                    wa[d][0] = *(const bf16x8*)(pw0 + o); wa[d][1] = *(const bf16x8*)(pw0 + o + 8);
                    wb[d][0] = *(const bf16x8*)(pw1 + o); wb[d][1] = *(const bf16x8*)(pw1 + o + 8);
                }
            }
        }
        const unsigned rl = rb * 32 + r;
        if (E.mode == 0) {
            const float rs = __builtin_amdgcn_rsqf(E.ss[MP + rl] * (1.0f / 1024.0f) + 1e-6f);
            bf16_t* hp = E.H + (size_t)MP * 2816 + (rl * 2816u + 32 * cb + 4 * h);
#pragma unroll
            for (int c = 0; c < 4; ++c) {
                float hv[4];
#pragma unroll
                for (int j = 0; j < 4; ++j) { const float g = c0[4 * c + j] * rs, up = c1[4 * c + j] * rs; hv[j] = g * up * __builtin_amdgcn_rcpf(1.0f + __expf(-g)); }
                u32x2 o; o.x = pk(hv[0], hv[1]); o.y = pk(hv[2], hv[3]); *(u32x2*)(hp + 8 * c) = o;
            }
        } else if (E.mode == 1) {
            float part = 0.f;
            bf16_t* bp = E.XB + (size_t)MP * 1024 + (rl * 1024u + 64 * cb + 4 * h);
            u32x2 win[2][4];
#pragma unroll
            for (int blk = 0; blk < 2; ++blk)
#pragma unroll
                for (int c = 0; c < 4; ++c) win[blk][c] = *(const u32x2*)(bp + 32 * blk + 8 * c);
#pragma unroll
            for (int blk = 0; blk < 2; ++blk)
#pragma unroll
                for (int c = 0; c < 4; ++c) {
                    const u32x2 w = win[blk][c];
                    f32x4 x; x[0] = __builtin_bit_cast(float, w.x << 16); x[1] = __builtin_bit_cast(float, w.x & 0xffff0000u); x[2] = __builtin_bit_cast(float, w.y << 16); x[3] = __builtin_bit_cast(float, w.y & 0xffff0000u);
#pragma unroll
                    for (int j = 0; j < 4; ++j) { x[j] += E.sc * (blk ? c1[4 * c + j] : c0[4 * c + j]); part += x[j] * x[j]; }
                    u32x2 o; o.x = pk(x[0], x[1]); o.y = pk(x[2], x[3]); *(u32x2*)(bp + 32 * blk + 8 * c) = o;
                }
            part += __shfl_xor(part, 32);
            if (h == 0) unsafeAtomicAdd(E.ssn + MP + rl, part);
        } else {
            const float rs = __builtin_amdgcn_rsqf(E.ss[MP + rl] * (1.0f / 1024.0f) + 1e-6f);
#pragma unroll
            for (int blk = 0; blk < 2; ++blk) {
                const int n0 = 64 * cb + 32 * blk;
                pg8::Unit u; u.pm = 256; u.pn = n0 >> 8;
                const pg8::Route rt = pg8::route_unit(E.pc, u);
                const unsigned rbw = rt.grp ? (rl >> 5) * (unsigned)rt.grp + (rl & 31u) : rl, cl = (unsigned)(n0 & 255) + 4 * h;
#pragma unroll
                for (int c = 0; c < 4; ++c) {
                    f32x4 v;
#pragma unroll
                    for (int j = 0; j < 4; ++j) v[j] = (blk ? c1[4 * c + j] : c0[4 * c + j]) * rs;
                    if (rt.b) { u32x2 o; o.x = pk(v[0], v[1]); o.y = pk(v[2], v[3]); *(u32x2*)(rt.b + (rbw * (unsigned)rt.ldb + cl + 8 * c)) = o; }
                    if (rt.f) *(f32x4*)(rt.f + (rl * (unsigned)rt.ldf + cl + 8 * c)) = v;
                }
            }
        }
    }
}

#define XB_TMO      128
#define XB_XCNT(j)  (256  + 64 * (j))
#define XB_XSUB(j)  (1280 + 64 * (j))
#define XB_XGEN(j)  (2304 + 64 * (j))
#define XB_TOP      3328
#define XB_TOPGEN   3392
#define XCD_BAR_WORDS 3456
#define XB_SPIN_CAP (1u << 18)

__device__ __forceinline__ unsigned xb_ld(unsigned* p)              { return __hip_atomic_load(p, __ATOMIC_RELAXED, __HIP_MEMORY_SCOPE_AGENT); }
__device__ __forceinline__ unsigned xb_add(unsigned* p, unsigned v) { return __hip_atomic_fetch_add(p, v, __ATOMIC_RELAXED, __HIP_MEMORY_SCOPE_AGENT); }
__device__ __forceinline__ unsigned xb_xcc_id() { return (unsigned)__builtin_amdgcn_s_getreg((3 << 11) | 20) & 0xFu; }
#define XB_SPIN(cond, bar) do { unsigned _sp = 0; while (cond) { __builtin_amdgcn_s_sleep(1); \
    if ((++_sp & 255u) == 0u) { if (xb_ld(&(bar)[XB_TMO])) break; if (_sp > XB_SPIN_CAP) { atomicAdd(&(bar)[XB_TMO], 1u); break; } } } } while (0)

struct XcdBarrier {
    unsigned* bar; unsigned x;
    volatile LAS unsigned* st;
};

__device__ __forceinline__ XcdBarrier xcd_barrier_post(unsigned* bar, volatile LAS unsigned* st) {
    XcdBarrier b; b.bar = bar; b.x = xb_xcc_id(); b.st = st;
    if (threadIdx.x == 0) (void)xb_add(&bar[XB_XCNT(b.x)], 1u);
    return b;
}
__device__ __forceinline__ void xcd_barrier_complete(unsigned* bar, unsigned x, unsigned& nloc, unsigned& nx) {
    const unsigned G = gridDim.x * gridDim.y * gridDim.z;
    unsigned sum, cnt, mine, sp = 0u;
    for (;;) {
        sum = 0u; cnt = 0u; mine = 0u;
#pragma unroll
        for (unsigned j = 0; j < 16; ++j) { const unsigned c = xb_ld(&bar[XB_XCNT(j)]); sum += c; cnt += (c > 0u) ? 1u : 0u; mine = (j == x) ? c : mine; }
        if (sum == G) break;
        __builtin_amdgcn_s_sleep(1);
        if ((++sp & 255u) == 0u) { if (xb_ld(&bar[XB_TMO])) break; if (sp > XB_SPIN_CAP) { atomicAdd(&bar[XB_TMO], 1u); break; } }
    }
    nloc = mine > 0u ? mine : 1u; nx = cnt > 0u ? cnt : 1u;
}

__device__ __forceinline__ void xcd_barrier(const XcdBarrier& b) {
    asm volatile("s_waitcnt vmcnt(0)" ::: "memory");
    __syncthreads();
    if (threadIdx.x == 0) {
        unsigned* bar = b.bar;
        __builtin_amdgcn_s_waitcnt(0);
        unsigned nloc = b.st[0], nx = b.st[1];
        if (nloc == 0u) { xcd_barrier_complete(bar, b.x, nloc, nx); b.st[0] = nloc; b.st[1] = nx; }
        const unsigned old = xb_add(&bar[XB_XSUB(b.x)], 1u);
        const unsigned gen = old / nloc;
        if (old + 1u == (gen + 1u) * nloc) {
            __builtin_amdgcn_fence(__ATOMIC_RELEASE, "agent");
            asm volatile("s_waitcnt vmcnt(0)" ::: "memory");
            const unsigned og = xb_add(&bar[XB_TOP], 1u);
            const unsigned tg = og / nx;
            if (og + 1u == (tg + 1u) * nx) xb_add(&bar[XB_TOPGEN], 1u);
            else XB_SPIN(xb_ld(&bar[XB_TOPGEN]) == tg, bar);
            __builtin_amdgcn_fence(__ATOMIC_ACQUIRE, "agent");
            xb_add(&bar[XB_XGEN(b.x)], 1u);
            asm volatile("s_waitcnt vmcnt(0)" ::: "memory");
        } else {
            XB_SPIN(xb_ld(&bar[XB_XGEN(b.x)]) == gen, bar);
            __builtin_amdgcn_fence(__ATOMIC_ACQUIRE, "agent");
            asm volatile("s_waitcnt vmcnt(0)" ::: "memory");
        }
    }
    __syncthreads();
}


struct Ptrs {
    float* out; float* ss;
    bf16_t *W, *XB, *HID, *QO, *Kp, *Vp, *KBp, *VBp, *MEMB, *Ks, *Vs, *KBs, *VBs, *MKV, *MKS, *MVS;
};

__device__ __forceinline__ void attn_phase(const Ptrs& P, int l, const float* relb, LAS unsigned char* lds) {
    const int tid = opaque_tid(), lane = tid & 63, wid = __builtin_amdgcn_readfirstlane(tid >> 6);
    LAS unsigned char* vl = lds + wid * 4608;
    LAS float* biasL = (LAS float*)(lds + 40960);
    if (l >= 2) {
        for (int i = tid; i < 12 * 257; i += 512) biasL[i] = relb[(size_t)(l - 2) * 12 * 257 + i] * LOG2E;
        __syncthreads();
    }
    constexpr int NW1 = 3072, NW3 = 1024, NS = 128;
    const int gwm = wid * gridDim.x + blockIdx.x;
    const int nrounds = (NW1 + NW3 + (int)gridDim.x - 1) / (int)gridDim.x;
    for (int it = -1; it < nrounds; ++it) {
        const bf16_t *K, *V; bf16_t* Q; int kp = 768, kt_lo = 0, kt_hi = 0, qpos0 = 0, kpos0 = 0, mode, hd = 0;
        if (it < 0) {
            if (gwm >= NS) continue;
            if (gwm < 96) {
                const int b = gwm / 12; hd = gwm - b * 12;
                Q = P.QO + ((size_t)MP + 32 * b) * 1024 + hd * 64; qpos0 = 1024;
                if (l < 2) { mode = 0; K = P.Ks + (size_t)l * KS_L + (size_t)b * 1056 * 768 + hd * 64; V = P.Vs + (size_t)l * KS_L + (size_t)b * 1056 * 768 + hd * 64; kt_hi = 32; }
                else { mode = 1; K = P.KBs + (size_t)b * 544 * 768 + hd * 64; V = P.VBs + (size_t)b * 544 * 768 + hd * 64; kt_hi = 16; kpos0 = 512; }
            } else {
                const int v = gwm - 96, b = v >> 2, mh = v & 3;
                mode = 2; Q = P.QO + ((size_t)MP + 32 * b) * 1024 + 768 + mh * 64;
                K = P.MKS + ((size_t)(l * 8 + b) * 256) * 256 + mh * 64; V = P.MVS + ((size_t)(l * 8 + b) * 256) * 256 + mh * 64; kp = 256; kt_hi = 7;
            }
        } else {
            const int wu = it * (int)gridDim.x + (int)blockIdx.x;
            if (wu >= NW1 + NW3) continue;
            if (wu < NW1) {
                const int qb8 = wu / 384, bh = wu - qb8 * 384, qb = 8 * qb8 + wid, b = bh / 12; hd = bh - b * 12;
                Q = P.QO + ((size_t)b * 2048 + 32 * qb) * 1024 + hd * 64; qpos0 = 32 * qb;
                if (l < 2) { mode = 0; K = P.Kp + (size_t)b * 2048 * 768 + hd * 64; V = P.Vp + (size_t)b * 2048 * 768 + hd * 64; kt_hi = qb; }
                else { mode = 1; const int c = qb >> 1; K = P.KBp + (size_t)b * 2048 * 768 + hd * 64; V = P.VBp + (size_t)b * 2048 * 768 + hd * 64; kt_lo = c > 8 ? 2 * (c - 8) : 0; kt_hi = 2 * c + 1; }
            } else {
                const int v = wu - NW1, qb8 = v >> 7, bh = v & 127, b = bh >> 2, mh = bh & 3, qb = 8 * qb8 + wid;
                mode = 2; Q = P.QO + ((size_t)b * 2048 + 32 * qb) * 1024 + 768 + mh * 64;
                K = P.MKV + (size_t)b * 256 * 2048 + l * 512 + mh * 64; V = K + 256; kp = 2048; kt_hi = 7;
            }
        }
        if (mode == 0) attn_unit<0>(Q, K, V, Q, kp, kt_lo, kt_hi, qpos0, kpos0, vl, biasL, lane);
        else if (mode == 1) attn_unit<1>(Q, K, V, Q, kp, kt_lo, kt_hi, qpos0, kpos0, vl, biasL + hd * 257, lane);
        else attn_unit<2>(Q, K, V, Q, kp, kt_lo, kt_hi, qpos0, kpos0, vl, biasL, lane);
    }
    __syncthreads();
}

__global__ void __launch_bounds__(512) yoco_fwd(Args a) {
    extern __shared__ __attribute__((aligned(16))) unsigned char smem[];
    LAS unsigned char* lds = (LAS unsigned char*)smem;
    cg::grid_group grid = cg::this_grid();
    const int G = gridDim.x, NGW = G * 8;
    unsigned char* ws = a.ws;
    Ptrs P;
    P.out = a.out; P.ss = (float*)(ws + WS_SS);
    P.W = (bf16_t*)(ws + WS_W); P.XB = (bf16_t*)(ws + WS_XB); P.HID = (bf16_t*)(ws + WS_UN); P.QO = (bf16_t*)(ws + WS_QO); P.Kp = (bf16_t*)(ws + WS_KP); P.Vp = (bf16_t*)(ws + WS_VP);
    P.KBp = (bf16_t*)(ws + WS_KBP); P.VBp = (bf16_t*)(ws + WS_VBP); P.MEMB = (bf16_t*)(ws + WS_MEMB); P.Ks = (bf16_t*)(ws + WS_KS); P.Vs = (bf16_t*)(ws + WS_VS);
    P.KBs = (bf16_t*)(ws + WS_KBS); P.VBs = (bf16_t*)(ws + WS_VBS); P.MKV = (bf16_t*)(ws + WS_MKV); P.MKS = (bf16_t*)(ws + WS_MKS); P.MVS = (bf16_t*)(ws + WS_MVS);
    volatile LAS unsigned* bst = (volatile LAS unsigned*)(lds + LDS_BYTES - 64);
    if (threadIdx.x == 0) { bst[0] = 0u; bst[1] = 0u; }
    __syncthreads();
    const XcdBarrier xbar = xcd_barrier_post((unsigned*)(ws + WS_BAR), bst);
    float* Y = a.out;

    {
        const int tid = opaque_tid(), lane = tid & 63, wid = __builtin_amdgcn_readfirstlane(tid >> 6), gw = blockIdx.x * 8 + wid;
        LAS float* scr = (LAS float*)(lds + wid * 8448); int cbase = 0;
        for (int l = 0; l < 4; ++l) {
            bf16_t* wl = P.W + (size_t)l * W_L;
            conv_w(a.in[10] + (size_t)l * 1024 * 5632, 1024, 5632, wl + W_GU1, 0, a.in[9] + l * 1024, true, scr, gw, NGW, lane, cbase);
            conv_w(a.in[11] + (size_t)l * 2816 * 1024, 2816, 1024, wl + W_D1, 0, nullptr, false, scr, gw, NGW, lane, cbase);
            conv_w(a.in[22] + (size_t)l * 1024 * 5632, 1024, 5632, wl + W_GU2, 0, a.in[21] + l * 1024, true, scr, gw, NGW, lane, cbase);
            conv_w(a.in[23] + (size_t)l * 2816 * 1024, 2816, 1024, wl + W_D2, 0, nullptr, false, scr, gw, NGW, lane, cbase);
            conv_w(a.in[15] + (size_t)l * 1024 * 1024, 1024, 1024, P.W + W_OUT + (size_t)l * 1048576, 0, nullptr, false, scr, gw, NGW, lane, cbase);
            conv_w(a.in[17] + (size_t)l * 1024 * 512, 1024, 512, P.W + W_MEM, l * 512, a.in[16] + l * 1024, false, scr, gw, NGW, lane, cbase);
            if (l < 2) conv_w(a.in[13] + (size_t)l * 1024 * 2560, 1024, 2560, P.W + W_INA + (size_t)l * 2621440, 0, a.in[12] + l * 1024, false, scr, gw, NGW, lane, cbase);
            else       conv_w(a.in[14] + (size_t)(l - 2) * 1024 * 1024, 1024, 1024, P.W + W_INB + (size_t)(l - 2) * 1048576, 0, a.in[12] + l * 1024, false, scr, gw, NGW, lane, cbase);
        }
        conv_w(a.in[19], 1024, 1536, P.W + W_KVB, 0, a.in[18], false, scr, gw, NGW, lane, cbase);
        for (int row = gw; row < MT; row += 4 * NGW) {
            f32x4 v[4][4]; float sq[4];
#pragma unroll
            for (int q = 0; q < 4; ++q) { const int rw = row + q * NGW; sq[q] = 0.f;
                if (rw < MT) { const float* src = rw < MP ? a.in[0] + (size_t)rw * 1024 : a.in[1] + (size_t)(rw - MP) * 1024;
#pragma unroll
                    for (int j = 0; j < 4; ++j) v[q][j] = ((const f32x4*)src)[lane + 64 * j]; } }
#pragma unroll
            for (int q = 0; q < 4; ++q) { const int rw = row + q * NGW;
                if (rw < MT) {
#pragma unroll
                    for (int j = 0; j < 4; ++j) sq[q] += (v[q][j][0] * v[q][j][0] + v[q][j][1] * v[q][j][1]) + (v[q][j][2] * v[q][j][2] + v[q][j][3] * v[q][j][3]);
                    sq[q] = wave_sum(sq[q]);
#pragma unroll
                    for (int j = 0; j < 4; ++j) { u32x2 o; o.x = pk(v[q][j][0], v[q][j][1]); o.y = pk(v[q][j][2], v[q][j][3]); ((u32x2*)(P.XB + (size_t)rw * 1024))[lane + 64 * j] = o; }
                    if (lane == 0) P.ss[rw] = sq[q];
                } }
        }
        for (int row = gw; row < 8192; row += NGW) row1024(a.in[8] + (size_t)row * 1024, nullptr, P.MEMB + (size_t)row * 1024, P.ss + SS_MEM + row, lane);
        cvt_rows(a.in[2], P.Ks, 16384, 768, 1024, 1056, gw, NGW, lane);
        cvt_rows(a.in[3], P.Vs, 16384, 768, 1024, 1056, gw, NGW, lane);
        cvt_rows(a.in[4], P.KBs, 4096, 768, 512, 544, gw, NGW, lane);
        cvt_rows(a.in[5], P.VBs, 4096, 768, 512, 544, gw, NGW, lane);
        cvt_rows(a.in[6], P.MKS, 8192, 256, 1, 1, gw, NGW, lane);
        cvt_rows(a.in[7], P.MVS, 8192, 256, 1, 1, gw, NGW, lane);
        for (size_t i = (size_t)blockIdx.x * 512 + tid; i < 12 * SS_STRIDE; i += (size_t)G * 512) P.ss[SS_STRIDE + i] = 0.f;
    }
    grid.sync();

    pg8::StaticOrder so;
    pg8::ProjCtx pc; pc.kind = 0; pc.l = 0; pc.QO = P.QO; pc.Kp = P.Kp; pc.Vp = P.Vp; pc.Ks = P.Ks; pc.Vs = P.Vs; pc.KBp = P.KBp; pc.VBp = P.VBp; pc.KBs = P.KBs; pc.VBs = P.VBs; pc.MKV = P.MKV; pc.out = a.out;
    {
        pg8::Gemm g{P.MEMB, P.W + W_MEM, 8192, 2048, 1024}; so.init(8192, 2048, G, blockIdx.x);
        pg8::EpiProj e; e.ss = P.ss + SS_MEM; e.c = pc; e.c.kind = 3;
        pg8::gemm_phase<pg8::EpiProj, pg8::StaticOrder, true, true>(lds, g, so, e);
    }
#pragma unroll 1
    for (int l = 0; l < 4; ++l) {
        bf16_t* wl = P.W + (size_t)l * W_L;
        float* ss0 = P.ss + (size_t)(3 * l) * SS_STRIDE;
        { SmpEpi se{}; se.mode = 0; se.ss = ss0; se.H = P.HID; sample_gemm(P.XB + (size_t)MP * 1024, wl + W_GU1, 5632, 1024, se); }
        { pg8::Gemm g{P.XB, wl + W_GU1, MP, 5632, 1024}; so.init(MP, 5632, G, blockIdx.x); pg8::EpiGU e{P.HID, ss0};
          pg8::gemm_phase<pg8::EpiGU, pg8::StaticOrder, true, true>(lds, g, so, e); }
        xcd_barrier(xbar);
        { SmpEpi se{}; se.mode = 1; se.XB = P.XB; se.ssn = ss0 + SS_STRIDE; se.sc = 0.5f; sample_gemm(P.HID + (size_t)MP * 2816, wl + W_D1, 1024, 2816, se); }
        { pg8::Gemm g{P.HID, wl + W_D1, MP, 1024, 2816}; so.init(MP, 1024, G, blockIdx.x); pg8::EpiRes e{P.XB, ss0 + SS_STRIDE, 0.5f};
          pg8::gemm_phase<pg8::EpiRes, pg8::StaticOrder, true, true>(lds, g, so, e); }
        xcd_barrier(xbar);
        {
            pg8::EpiProj e; e.ss = ss0 + SS_STRIDE; e.c = pc; e.c.l = l;
            if (l < 2) { e.c.kind = 0; e.c.Ks = P.Ks + (size_t)l * KS_L; e.c.Vs = P.Vs + (size_t)l * KS_L;
                { SmpEpi se{}; se.mode = 2; se.ss = e.ss; se.pc = e.c; sample_gemm(P.XB + (size_t)MP * 1024, P.W + W_INA + (size_t)l * 2621440, 2560, 1024, se); }
                pg8::Gemm g{P.XB, P.W + W_INA + (size_t)l * 2621440, MP, 2560, 1024}; so.init(MP, 2560, G, blockIdx.x);
                pg8::gemm_phase<pg8::EpiProj, pg8::StaticOrder, true, true>(lds, g, so, e); }
            else { e.c.kind = 1;
                { SmpEpi se{}; se.mode = 2; se.ss = e.ss; se.pc = e.c; sample_gemm(P.XB + (size_t)MP * 1024, P.W + W_INB + (size_t)(l - 2) * 1048576, 1024, 1024, se); }
                pg8::Gemm g{P.XB, P.W + W_INB + (size_t)(l - 2) * 1048576, MP, 1024, 1024}; so.init(MP, 1024, G, blockIdx.x);
                pg8::gemm_phase<pg8::EpiProj, pg8::StaticOrder, true, true>(lds, g, so, e); }
        }
        xcd_barrier(xbar);
        attn_phase(P, l, a.in[20], lds);
        xcd_barrier(xbar);
        { SmpEpi se{}; se.mode = 1; se.XB = P.XB; se.ssn = ss0 + 2 * SS_STRIDE; se.sc = 1.0f; sample_gemm(P.QO + (size_t)MP * 1024, P.W + W_OUT + (size_t)l * 1048576, 1024, 1024, se); }
        { pg8::Gemm g{P.QO, P.W + W_OUT + (size_t)l * 1048576, MP, 1024, 1024}; so.init(MP, 1024, G, blockIdx.x); pg8::EpiRes e{P.XB, ss0 + 2 * SS_STRIDE, 1.0f};
          pg8::gemm_phase<pg8::EpiRes, pg8::StaticOrder, true, true>(lds, g, so, e); }
        xcd_barrier(xbar);
        { SmpEpi se{}; se.mode = 0; se.ss = ss0 + 2 * SS_STRIDE; se.H = P.HID; sample_gemm(P.XB + (size_t)MP * 1024, wl + W_GU2, 5632, 1024, se); }
        { pg8::Gemm g{P.XB, wl + W_GU2, MP, 5632, 1024}; so.init(MP, 5632, G, blockIdx.x); pg8::EpiGU e{P.HID, ss0 + 2 * SS_STRIDE};
          pg8::gemm_phase<pg8::EpiGU, pg8::StaticOrder, true, true>(lds, g, so, e); }
        xcd_barrier(xbar);
        { SmpEpi se{}; se.mode = 1; se.XB = P.XB; se.ssn = ss0 + 3 * SS_STRIDE; se.sc = 0.5f; sample_gemm(P.HID + (size_t)MP * 2816, wl + W_D2, 1024, 2816, se); }
        { pg8::Gemm g{P.HID, wl + W_D2, MP, 1024, 2816}; so.init(MP, 1024, G, blockIdx.x); pg8::EpiRes e{P.XB, ss0 + 3 * SS_STRIDE, 0.5f};
          pg8::gemm_phase<pg8::EpiRes, pg8::StaticOrder, true, true>(lds, g, so, e); }
        xcd_barrier(xbar);
        if (l == 1) {
            pg8::EpiProj e; e.ss = ss0 + 3 * SS_STRIDE; e.c = pc; e.c.kind = 2;
            { SmpEpi se{}; se.mode = 2; se.ss = e.ss; se.pc = e.c; sample_gemm(P.XB + (size_t)MP * 1024, P.W + W_KVB, 1536, 1024, se); }
            pg8::Gemm g{P.XB, P.W + W_KVB, MP, 1536, 1024}; so.init(MP, 1536, G, blockIdx.x);
            pg8::gemm_phase<pg8::EpiProj, pg8::StaticOrder, true, true>(lds, g, so, e);
        }
    }
    {
        const int tid = opaque_tid(), lane = tid & 63, wid = __builtin_amdgcn_readfirstlane(tid >> 6), gw = blockIdx.x * 8 + wid;
        const float* ssf = P.ss + 12 * SS_STRIDE; const float* gf = a.in[24];
        f32x4 gg[4];
#pragma unroll
        for (int j = 0; j < 4; ++j) gg[j] = ((const f32x4*)gf)[lane + 64 * j];
        for (int row = gw; row < MT; row += 4 * NGW) {
            u32x2 w[4][4]; float rs[4];
#pragma unroll
            for (int q = 0; q < 4; ++q) { const int rw = row + q * NGW;
                if (rw < MT) { rs[q] = ssf[rw]; const u32x2* xp = (const u32x2*)(P.XB + (size_t)rw * 1024);
#pragma unroll
                    for (int j = 0; j < 4; ++j) w[q][j] = xp[lane + 64 * j]; } }
#pragma unroll
            for (int q = 0; q < 4; ++q) { const int rw = row + q * NGW;
                if (rw < MT) { const float r1 = __builtin_amdgcn_rsqf(rs[q] * (1.0f / 1024.0f) + 1e-6f); f32x4* yp = (f32x4*)(Y + (size_t)rw * 1024);
#pragma unroll
                    for (int j = 0; j < 4; ++j) { f32x4 v;
                        v[0] = __builtin_bit_cast(float, w[q][j].x << 16); v[1] = __builtin_bit_cast(float, w[q][j].x & 0xffff0000u); v[2] = __builtin_bit_cast(float, w[q][j].y << 16); v[3] = __builtin_bit_cast(float, w[q][j].y & 0xffff0000u);
                        yp[lane + 64 * j] = v * r1 * gg[j]; } } }
        }
    }
}
}

extern "C" void kernel_launch(void* const* d_in, const int* in_sizes, int n_in, void* d_out, int out_size, void* d_ws, size_t ws_size, hipStream_t stream) {
    static int grid = 0;
    if (grid == 0) {
        if (n_in != 25 || (size_t)out_size != pg8::O_END || ws_size < mk::WS_END) { fprintf(stderr, "kernel_launch: unexpected shapes: n_in %d out %d ws %zu\n", n_in, out_size, ws_size); grid = -1; return; }
        int dev = 0, cus = 0, per_cu = 0;
        hipGetDevice(&dev); hipDeviceGetAttribute(&cus, hipDeviceAttributeMultiprocessorCount, dev);
        if (hipFuncSetAttribute((const void*)mk::yoco_fwd, hipFuncAttributeMaxDynamicSharedMemorySize, mk::LDS_BYTES) != hipSuccess) { fprintf(stderr, "kernel_launch: hipFuncSetAttribute failed\n"); grid = -1; return; }
        if (hipOccupancyMaxActiveBlocksPerMultiprocessor(&per_cu, (const void*)mk::yoco_fwd, 512, mk::LDS_BYTES) != hipSuccess || per_cu < 1) { fprintf(stderr, "kernel_launch: occupancy query says %d\n", per_cu); per_cu = 1; }
        (void)hipGetLastError();
        grid = cus;
    }
    if (grid < 0) return;
    if (hipMemsetAsync((char*)d_ws + mk::WS_BAR, 0, mk::BAR_BYTES, stream) != hipSuccess) { fprintf(stderr, "kernel_launch: hipMemsetAsync failed\n"); return; }
    mk::Args a{};
    for (int i = 0; i < 25; ++i) a.in[i] = (const float*)d_in[i];
    a.out = (float*)d_out; a.ws = (unsigned char*)d_ws;
    void* args[] = {&a};
    hipError_t e = hipLaunchCooperativeKernel((const void*)mk::yoco_fwd, dim3(grid), dim3(512), args, mk::LDS_BYTES, stream);
    if (e != hipSuccess) fprintf(stderr, "cooperative launch failed: %s (grid %d)\n", hipGetErrorString(e), grid);
}
```

```cpp
#include <hip/hip_runtime.h>
#include <hip/hip_cooperative_groups.h>
#include <cstdio>
#include <cstdint>
namespace cg = cooperative_groups;
namespace pg8 {
#define PG8_LAS __attribute__((address_space(3)))
typedef unsigned short bf16_t;
typedef short bf16x8 __attribute__((ext_vector_type(8)));
typedef float f32x4 __attribute__((ext_vector_type(4)));
typedef unsigned u32x4 __attribute__((ext_vector_type(4)));
constexpr int BM = 256, BK = 64, HALF = 128, HTB = HALF * BK * 2  , STAGE_BYTES = 8 * HTB, NXCD = 8, WGM = 8;

__host__ __device__ __forceinline__ int lds_byte(int r, int c) { const int st = (r >> 4) * 2 + (c >> 5), rr = r & 15, cc = c & 31, ob = rr * 64 + cc * 2; return st * 1024 + (ob ^ (((ob >> 9) & 1) << 5)); }
__host__ __device__ __forceinline__ void stage_rc(int b, int& R, int& C) { const int st = b / 1024, sb = b % 1024, swz = sb ^ (((sb >> 9) & 1) << 5); R = (st >> 1) * 16 + swz / 64; C = (st & 1) * 32 + (swz % 64) / 2; }
__host__ __device__ __forceinline__ int perm32(int rho) { const int n = rho >> 4, i = rho & 15; return 8 * (i >> 2) + 4 * n + (i & 3); }

struct Unit { int pm, pn; };
struct Gemm { const bf16_t* A; const bf16_t* Bt; int M, N, K; };

struct StaticOrder {
    int nM, nN, nwg, G, c;
    __host__ __device__ void init(int M, int N, int G_, int c_) { nM = M / BM; nN = N / BM; nwg = nM * nN; G = G_; c = c_; }
    __host__ __device__ bool next(int i, Unit& u) const {
        const long L = (long)i * G + c; if (L >= nwg) return false;
        int wgid = (int)L; { const int q = nwg / NXCD, r = nwg % NXCD, xcd = wgid % NXCD, off = wgid / NXCD; wgid = (xcd < r ? xcd * (q + 1) : r * (q + 1) + (xcd - r) * q) + off; }
        const int nig = WGM * nN, gid = wgid / nig, fm = gid * WGM, gsz = (nM - fm) < WGM ? (nM - fm) : WGM;
        u.pm = fm + ((wgid % nig) % gsz); u.pn = (wgid % nig) / gsz; return true;
    }
    __device__ __forceinline__ void a_ready(const Unit&) const {}
    __device__ __forceinline__ void done(const Unit&) const {}
};

__device__ __forceinline__ unsigned cvt_pk_bf16(float lo, float hi) { unsigned r; asm volatile("v_cvt_pk_bf16_f32 %0, %1, %2" : "=v"(r) : "v"(lo), "v"(hi)); return r; }

__device__ __forceinline__ u32x4 pack8(const f32x4& a, const f32x4& b) { u32x4 w; w.x = cvt_pk_bf16(a[0], a[1]); w.y = cvt_pk_bf16(a[2], a[3]); w.z = cvt_pk_bf16(b[0], b[1]); w.w = cvt_pk_bf16(b[2], b[3]); return w; }

struct EpiGU {
    static constexpr bool PERM = true, AFTER_DRAIN = false;
    bf16_t* H; const float* ss;
    __device__ __forceinline__ void operator()(const f32x4 (&acc)[2][2][4][2], const Unit& u, int wr, int wc, int fr_, int fq_) const {
        int fr = fr_, fq = fq_; asm volatile("" : "+v"(fr), "+v"(fq));
        bf16_t* Hu = H + (size_t)u.pm * BM * 2816 + u.pn * 128; const float* ssu = ss + u.pm * BM;
        const unsigned rl0 = wr * 64 + fr, cl0 = wc * 32 + 8 * fq;
        float rsv[2][4];
#pragma unroll
        for (int ai = 0; ai < 2; ++ai)
#pragma unroll
            for (int m = 0; m < 4; ++m) rsv[ai][m] = ssu[rl0 + ai * HALF + m * 16];
#pragma unroll
        for (int ai = 0; ai < 2; ++ai)
#pragma unroll
            for (int m = 0; m < 4; ++m) {
                const unsigned rl = rl0 + ai * HALF + m * 16;
                const float rs = __builtin_amdgcn_rsqf(rsv[ai][m] * (1.0f / 1024.0f) + 1e-6f);
                f32x4 h[2]; const float k1 = rs * -1.4426950408889634f, rs2 = rs * rs;
#pragma unroll
                for (int n = 0; n < 2; ++n) {
                    const f32x4 t = acc[ai][0][m][n] * k1, gu = acc[ai][0][m][n] * acc[ai][1][m][n];
                    f32x4 e;
#pragma unroll
                    for (int j = 0; j < 4; ++j) e[j] = __builtin_amdgcn_exp2f(t[j]);
                    e = e + 1.0f;
#pragma unroll
                    for (int j = 0; j < 4; ++j) e[j] = __builtin_amdgcn_rcpf(e[j]);
                    h[n] = gu * (e * rs2);
                }
                *(u32x4*)(Hu + (rl * 2816u + cl0)) = pack8(h[0], h[1]);
            }
    }
};

__device__ __forceinline__ f32x4 unpk_lo(const u32x4& w) { f32x4 r; r[0] = __builtin_bit_cast(float, w.x << 16); r[1] = __builtin_bit_cast(float, w.x & 0xffff0000u); r[2] = __builtin_bit_cast(float, w.y << 16); r[3] = __builtin_bit_cast(float, w.y & 0xffff0000u); return r; }
__device__ __forceinline__ f32x4 unpk_hi(const u32x4& w) { f32x4 r; r[0] = __builtin_bit_cast(float, w.z << 16); r[1] = __builtin_bit_cast(float, w.z & 0xffff0000u); r[2] = __builtin_bit_cast(float, w.w << 16); r[3] = __builtin_bit_cast(float, w.w & 0xffff0000u); return r; }
struct EpiRes {
    static constexpr bool PERM = true, AFTER_DRAIN = false;
    bf16_t* XB; float* ssn; float sc;
    __device__ __forceinline__ void operator()(const f32x4 (&acc)[2][2][4][2], const Unit& u, int wr, int wc, int fr_, int fq_) const {
        int fr = fr_, fq = fq_; asm volatile("" : "+v"(fr), "+v"(fq));
        bf16_t* XBu = XB + (size_t)u.pm * BM * 1024 + u.pn * BM; float* ssu = ssn + u.pm * BM;
        const unsigned rl0 = wr * 64 + fr, cl0 = wc * 32 + 8 * fq;
        u32x4 xin[2][4][2];
#pragma unroll
        for (int ai = 0; ai < 2; ++ai)
#pragma unroll
            for (int m = 0; m < 4; ++m)
#pragma unroll
                for (int bj = 0; bj < 2; ++bj) xin[ai][m][bj] = *(const u32x4*)(XBu + ((rl0 + ai * HALF + m * 16) * 1024u + cl0 + bj * HALF));
#pragma unroll
        for (int ai = 0; ai < 2; ++ai)
#pragma unroll
            for (int m = 0; m < 4; ++m) {
                const unsigned rl = rl0 + ai * HALF + m * 16;
                float part = 0.f;
#pragma unroll
                for (int bj = 0; bj < 2; ++bj) {
                    const unsigned off = rl * 1024u + cl0 + bj * HALF;
                    const u32x4 w = xin[ai][m][bj];
                    f32x4 x0 = unpk_lo(w), x1 = unpk_hi(w);
                    x0 = x0 + acc[ai][bj][m][0] * sc; x1 = x1 + acc[ai][bj][m][1] * sc;
                    *(u32x4*)(XBu + off) = pack8(x0, x1);
                    part += (x0[0] * x0[0] + x0[1] * x0[1]) + (x0[2] * x0[2] + x0[3] * x0[3]) + (x1[0] * x1[0] + x1[1] * x1[1]) + (x1[2] * x1[2] + x1[3] * x1[3]);
                }
                part += __shfl_xor(part, 16); part += __shfl_xor(part, 32);
                if (fq == 0) unsafeAtomicAdd(ssu + rl, part);
            }
    }
};

struct Route { bf16_t* b; float* f; int ldb, ldf, grp; };
struct ProjCtx {
    int kind, l;
    bf16_t *QO, *Kp, *Vp, *Ks, *Vs, *KBp, *VBp, *KBs, *VBs, *MKV;
    float* out;
};
constexpr size_t O_YS = 67108864, O_AKP = 67371008, O_AVP = 168034304, O_BKP = 268697600, O_BVP = 281280512, O_MKP = 293863424, O_MVP = 302252032,
                 O_AKS = 310640640, O_AVS = 311033856, O_BKS = 311427072, O_BVS = 311623680, O_END = 311820288;
__device__ __forceinline__ Route route_unit(const ProjCtx& c, const Unit& u) {
    Route r; r.b = nullptr; r.f = nullptr; r.ldb = 1024; r.ldf = 768; r.grp = 0;
    const int pm = u.pm, pn = u.pn; const bool smp = (pm == 256);
    if (c.kind == 0) {
        if (pn < 3 || pn == 9) { r.b = c.QO + (size_t)pm * 256 * 1024 + (pn == 9 ? 768 : pn * 256); r.ldb = 1024; }
        else { const bool isv = pn >= 6; const int ck = (pn - (isv ? 6 : 3)) * 256; r.ldb = 768; r.ldf = 768;
            if (!smp) { r.b = (isv ? c.Vp : c.Kp) + (size_t)pm * 256 * 768 + ck; r.f = c.out + (isv ? O_AVP : O_AKP) + ((size_t)c.l * 65536 + (size_t)pm * 256) * 768 + ck; }
            else { r.b = (isv ? c.Vs : c.Ks) + (size_t)1024 * 768 + ck; r.grp = 1056; r.f = c.out + (isv ? O_AVS : O_AKS) + (size_t)c.l * 256 * 768 + ck; } }
    } else if (c.kind == 1) {
        r.b = c.QO + (size_t)pm * 256 * 1024 + pn * 256; r.ldb = 1024;
    } else if (c.kind == 2) {
        const bool isv = pn >= 3; const int ck = (pn - (isv ? 3 : 0)) * 256; r.ldb = 768; r.ldf = 768;
        if (!smp) { r.b = (isv ? c.VBp : c.KBp) + (size_t)pm * 256 * 768 + ck;
            if ((pm & 7) >= 6) r.f = c.out + (isv ? O_BVP : O_BKP) + ((size_t)(pm >> 3) * 512 + (size_t)((pm & 7) - 6) * 256) * 768 + ck; }
        else { r.b = (isv ? c.VBs : c.KBs) + (size_t)512 * 768 + ck; r.grp = 544; r.f = c.out + (isv ? O_BVS : O_BKS) + ck; }
    } else {
        const int l = pn >> 1, kv = pn & 1;
        r.b = c.MKV + (size_t)pm * 256 * 2048 + pn * 256; r.ldb = 2048;
        r.f = c.out + (kv ? O_MVP : O_MKP) + ((size_t)(l * 32 + pm) * 256) * 256; r.ldf = 256;
    }
    return r;
}
struct EpiProj {
    static constexpr bool PERM = true, AFTER_DRAIN = false;
    const float* ss; ProjCtx c;
    __device__ __forceinline__ void operator()(const f32x4 (&acc)[2][2][4][2], const Unit& u, int wr, int wc, int fr_, int fq_) const {
        int fr = fr_, fq = fq_; asm volatile("" : "+v"(fr), "+v"(fq));
        const Route rt = route_unit(c, u);
        const unsigned rl0 = wr * 64 + fr, cl0 = wc * 32 + 8 * fq; const float* ssu = ss + u.pm * BM;
        float rsv[2][4];
#pragma unroll
        for (int ai = 0; ai < 2; ++ai)
#pragma unroll
            for (int m = 0; m < 4; ++m) rsv[ai][m] = ssu[rl0 + ai * HALF + m * 16];
#pragma unroll
        for (int ai = 0; ai < 2; ++ai)
#pragma unroll
            for (int m = 0; m < 4; ++m) {
                const unsigned rl = rl0 + ai * HALF + m * 16;
                const float rs = __builtin_amdgcn_rsqf(rsv[ai][m] * (1.0f / 1024.0f) + 1e-6f);
                const unsigned rb = rt.grp ? (rl >> 5) * (unsigned)rt.grp + (rl & 31u) : rl;
#pragma unroll
                for (int bj = 0; bj < 2; ++bj) {
                    const f32x4 v0 = acc[ai][bj][m][0] * rs, v1 = acc[ai][bj][m][1] * rs; const unsigned cl = cl0 + bj * HALF;
                    if (rt.b) *(u32x4*)(rt.b + (rb * (unsigned)rt.ldb + cl)) = pack8(v0, v1);
                    if (rt.f) { float* fp = rt.f + (rl * (unsigned)rt.ldf + cl); *(f32x4*)fp = v0; *(f32x4*)(fp + 4) = v1; }
                }
            }
    }
};

template <class Epi, class Sched, bool ALIGN_EPI = false, bool SP2 = false>
__device__ __forceinline__ void gemm_phase(PG8_LAS unsigned char* lds, const Gemm g, const Sched& S, const Epi& E) {
    int tid_ = threadIdx.x; asm volatile("" : "+v"(tid_));
    const int tid = tid_, wid = __builtin_amdgcn_readfirstlane(tid >> 6), lane = tid & 63, wr = wid >> 2, wc = wid & 3, fr = lane & 15, fq = lane >> 4;
    const int K = g.K, nt = K / BK;
    unsigned voffA[2], voffB[2];
#pragma unroll
    for (int i = 0; i < 2; ++i) { int R, C; stage_rc(tid * 16 + i * 8192, R, C); const int Rb = Epi::PERM ? ((R & ~31) + perm32(R & 31)) : R;
        voffA[i] = (unsigned)(R * K + C) * 2u; voffB[i] = (unsigned)(Rb * K + C) * 2u; }
    const size_t kstep = (size_t)(BK * 2);
    const size_t hstep = (size_t)HALF * K * 2;
    const size_t tstep = 2 * hstep;
    const unsigned ldsw = (unsigned)wid * 1024u;
    const int aoff = lds_byte(wr * 64 + fr, fq * 8), boff = lds_byte(wc * 32 + fr, fq * 8);
#define PG8_SA(b, h) (((b) * 2 + (h)) * HTB)
#define PG8_SB(b, h) ((4 + (b) * 2 + (h)) * HTB)
#define PG8_STAGE(bufoff, gbase, voff) do { _Pragma("unroll") for (int _i = 0; _i < 2; ++_i) \
        __builtin_amdgcn_global_load_lds((const unsigned*)((const char*)(gbase) + (voff)[_i]), (PG8_LAS unsigned*)(lds + (bufoff) + ldsw + _i * 8192), 16, 0, 0); } while (0)
#define PG8_LDA(dst, b, h) do { _Pragma("unroll") for (int m = 0; m < 4; ++m) _Pragma("unroll") for (int k = 0; k < 2; ++k) dst[m][k] = *(const PG8_LAS bf16x8*)(lds + PG8_SA(b, h) + aoff + m * 2048 + k * 1024); } while (0)
#define PG8_LDB(dst, b, h) do { _Pragma("unroll") for (int n = 0; n < 2; ++n) _Pragma("unroll") for (int k = 0; k < 2; ++k) dst[n][k] = *(const PG8_LAS bf16x8*)(lds + PG8_SB(b, h) + boff + n * 2048 + k * 1024); } while (0)
#define PG8_MMA(ai, bj, At, Bt) do { __builtin_amdgcn_s_setprio(1); _Pragma("unroll") for (int m = 0; m < 4; ++m) _Pragma("unroll") for (int n = 0; n < 2; ++n) _Pragma("unroll") for (int k = 0; k < 2; ++k) \
        acc[ai][bj][m][n] = __builtin_amdgcn_mfma_f32_16x16x32_bf16(Bt[n][k], At[m][k], acc[ai][bj][m][n], 0, 0, 0); __builtin_amdgcn_s_setprio(0); } while (0)
#define PG8_WAIT_V(n) asm volatile("s_waitcnt vmcnt(" #n ")" ::: "memory")
#define PG8_WAIT_L(n) asm volatile("s_waitcnt lgkmcnt(" #n ")" ::: "memory")
#define PG8_BAR __builtin_amdgcn_s_barrier()
#define PG8_SCHED __builtin_amdgcn_sched_barrier(0)
    Unit cur, nxt; int ui = 0;
    if (!S.next(0, cur)) return;
    f32x4 acc[2][2][4][2];
#pragma unroll
    for (int a = 0; a < 2; ++a)
#pragma unroll
        for (int b = 0; b < 2; ++b)
#pragma unroll
            for (int m = 0; m < 4; ++m)
#pragma unroll
                for (int n = 0; n < 2; ++n) acc[a][b][m][n] = (f32x4){0.f, 0.f, 0.f, 0.f};
    bf16x8 At[4][2], B0[2][2], B1[2][2];
    const char* cA = (const char*)g.A + (size_t)cur.pm * tstep; const char* cB = (const char*)g.Bt + (size_t)cur.pn * tstep;
    S.a_ready(cur);
    if constexpr (SP2) {
        PG8_STAGE(PG8_SB(0, 0), cB, voffB); PG8_STAGE(PG8_SB(0, 1), cB + hstep, voffB); PG8_STAGE(PG8_SA(0, 0), cA, voffA); PG8_STAGE(PG8_SA(0, 1), cA + hstep, voffA);
        if (wr == 1) PG8_BAR;
        PG8_WAIT_V(2); PG8_BAR;
        PG8_STAGE(PG8_SB(1, 0), cB + kstep, voffB); PG8_STAGE(PG8_SA(1, 0), cA + kstep, voffA); PG8_STAGE(PG8_SB(1, 1), cB + hstep + kstep, voffB);
        PG8_WAIT_V(6); PG8_BAR;
    } else {
        PG8_STAGE(PG8_SB(0, 0), cB, voffB); PG8_STAGE(PG8_SA(0, 0), cA, voffA); PG8_STAGE(PG8_SB(0, 1), cB + hstep, voffB); PG8_STAGE(PG8_SA(0, 1), cA + hstep, voffA);
        if (wr == 1) PG8_BAR;
        PG8_WAIT_V(4); PG8_BAR;
        PG8_STAGE(PG8_SB(1, 0), cB + kstep, voffB); PG8_STAGE(PG8_SA(1, 0), cA + kstep, voffA); PG8_STAGE(PG8_SB(1, 1), cB + hstep + kstep, voffB);
        PG8_WAIT_V(6); PG8_BAR;
    }
    for (;;) {
        const bool has_next = S.next(ui + 1, nxt);
        const char* nA = has_next ? (const char*)g.A + (size_t)nxt.pm * tstep : cA; const char* nB = has_next ? (const char*)g.Bt + (size_t)nxt.pn * tstep : cB;
        for (int t = 0; t < nt; t += 2) {
            const bool last = (t == nt - 2);
            const char* a1 = cA + (size_t)(t + 1) * kstep;
            const char* a2 = last ? nA : cA + (size_t)(t + 2) * kstep; const char* b2 = last ? nB : cB + (size_t)(t + 2) * kstep;
            const char* a3 = a2 + kstep; const char* b3 = b2 + kstep;
            if (last && has_next) S.a_ready(nxt);
            if constexpr (SP2) {
            PG8_LDB(B0, 0, 0); PG8_LDB(B1, 0, 1); PG8_SCHED; PG8_LDA(At, 0, 0); PG8_STAGE(PG8_SA(1, 1), a1 + hstep, voffA);
            PG8_WAIT_V(8); PG8_WAIT_L(0); PG8_BAR; PG8_MMA(0, 0, At, B0); PG8_MMA(0, 1, At, B1); PG8_BAR; PG8_SCHED;
            PG8_LDA(At, 0, 1); PG8_STAGE(PG8_SB(0, 0), b2, voffB); PG8_STAGE(PG8_SB(0, 1), b2 + hstep, voffB); PG8_STAGE(PG8_SA(0, 0), a2, voffA);
            PG8_WAIT_V(8); PG8_WAIT_L(0); PG8_BAR; PG8_MMA(1, 0, At, B0); PG8_MMA(1, 1, At, B1); PG8_BAR; PG8_SCHED;
            PG8_LDB(B0, 1, 0); PG8_LDB(B1, 1, 1); PG8_SCHED; PG8_LDA(At, 1, 0); PG8_STAGE(PG8_SA(0, 1), a2 + hstep, voffA);
            PG8_WAIT_V(8); PG8_WAIT_L(0); PG8_BAR; PG8_MMA(0, 0, At, B0); PG8_MMA(0, 1, At, B1); PG8_BAR; PG8_SCHED;
            PG8_LDA(At, 1, 1); PG8_STAGE(PG8_SB(1, 0), b3, voffB); PG8_STAGE(PG8_SB(1, 1), b3 + hstep, voffB); PG8_STAGE(PG8_SA(1, 0), a3, voffA);
            PG8_WAIT_V(8); PG8_WAIT_L(0); PG8_BAR; PG8_MMA(1, 0, At, B0); PG8_MMA(1, 1, At, B1); PG8_BAR; PG8_SCHED;
            } else {
            PG8_LDB(B0, 0, 0); PG8_SCHED; PG8_LDA(At, 0, 0); PG8_STAGE(PG8_SA(1, 1), a1 + hstep, voffA);
            PG8_WAIT_L(8); PG8_BAR; PG8_WAIT_L(0); PG8_MMA(0, 0, At, B0); PG8_BAR; PG8_SCHED;
            PG8_LDB(B1, 0, 1); PG8_STAGE(PG8_SB(0, 0), b2, voffB);
            PG8_BAR; PG8_WAIT_L(0); PG8_MMA(0, 1, At, B1); PG8_BAR;
            PG8_LDA(At, 0, 1); PG8_STAGE(PG8_SA(0, 0), a2, voffA);
            PG8_BAR; PG8_WAIT_L(0); PG8_MMA(1, 0, At, B0); PG8_BAR; PG8_SCHED;
            PG8_STAGE(PG8_SB(0, 1), b2 + hstep, voffB);
            PG8_WAIT_V(6); PG8_BAR; PG8_MMA(1, 1, At, B1); PG8_BAR;
            PG8_LDB(B0, 1, 0); PG8_SCHED; PG8_LDA(At, 1, 0); PG8_STAGE(PG8_SA(0, 1), a2 + hstep, voffA);
            PG8_WAIT_L(8); PG8_BAR; PG8_WAIT_L(0); PG8_MMA(0, 0, At, B0); PG8_BAR; PG8_SCHED;
            PG8_LDB(B1, 1, 1); PG8_STAGE(PG8_SB(1, 0), b3, voffB);
            PG8_BAR; PG8_WAIT_L(0); PG8_MMA(0, 1, At, B1); PG8_BAR;
            PG8_LDA(At, 1, 1); PG8_STAGE(PG8_SA(1, 0), a3, voffA);
            PG8_BAR; PG8_WAIT_L(0); PG8_MMA(1, 0, At, B0); PG8_BAR; PG8_SCHED;
            PG8_STAGE(PG8_SB(1, 1), b3 + hstep, voffB);
            PG8_WAIT_V(6); PG8_BAR; PG8_MMA(1, 1, At, B1); PG8_BAR;
            }
        }
        if constexpr (ALIGN_EPI) { if (wr == 0) PG8_BAR; }
        if constexpr (!Epi::AFTER_DRAIN) { E(acc, cur, wr, wc, fr, fq); S.done(cur); }
        if (!has_next) break;
#pragma unroll
        for (int a = 0; a < 2; ++a)
#pragma unroll
            for (int b = 0; b < 2; ++b)
#pragma unroll
                for (int m = 0; m < 4; ++m)
#pragma unroll
                    for (int n = 0; n < 2; ++n) acc[a][b][m][n] = (f32x4){0.f, 0.f, 0.f, 0.f};
        cur = nxt; cA = nA; cB = nB; ++ui;
        if constexpr (ALIGN_EPI) { if (wr == 1) PG8_BAR; }
    }
    PG8_WAIT_V(0);
    if constexpr (!ALIGN_EPI) { if (wr == 0) PG8_BAR; }
    PG8_BAR;
    if constexpr (Epi::AFTER_DRAIN) { E.fused(acc, cur, wr, wc, fr, fq, lds, wid, lane); S.done(cur); }
#undef PG8_SA
#undef PG8_SB
#undef PG8_STAGE
#undef PG8_LDA
#undef PG8_LDB
#undef PG8_MMA
#undef PG8_WAIT_V
#undef PG8_WAIT_L
#undef PG8_BAR
#undef PG8_SCHED
}
}

namespace mk {
using pg8::bf16_t; using pg8::bf16x8; using pg8::f32x4; using pg8::u32x4;
typedef float f32x16 __attribute__((ext_vector_type(16)));
typedef short s16x4 __attribute__((ext_vector_type(4)));
typedef short v4i16_t __attribute__((ext_vector_type(4)));
typedef unsigned u32x2 __attribute__((ext_vector_type(2)));
typedef float f32x2_t __attribute__((ext_vector_type(2)));
typedef __bf16 bf16x2_t __attribute__((ext_vector_type(2)));
#define LAS __attribute__((address_space(3)))

constexpr int MP = 65536, MT = 65792;
constexpr size_t MiB = 1u << 20;
constexpr size_t WS_SS = 0, WS_W = 4 * MiB, WS_XB = 166 * MiB, WS_UN = 295 * MiB, WS_QO = WS_UN, WS_KP = 424 * MiB, WS_VP = 520 * MiB, WS_KBP = 649 * MiB, WS_VBP = 745 * MiB,
                 WS_MEMB = WS_KBP, WS_KS = 841 * MiB, WS_VS = 866 * MiB, WS_KBS = 891 * MiB, WS_VBS = 898 * MiB, WS_MKV = 905 * MiB, WS_MKS = 937 * MiB, WS_MVS = 941 * MiB, WS_END = 945 * MiB;
constexpr size_t SS_STRIDE = 65792, SS_MEM = 13 * SS_STRIDE;
constexpr size_t WS_BAR = 4 * MiB - 65536, BAR_BYTES = 16384;
static_assert((SS_MEM + 8192 + 65792) * 4 <= WS_BAR, "barrier words clear of the ss rows");
constexpr size_t W_L = 17301504, W_GU1 = 0, W_D1 = 5767168, W_GU2 = 8650752, W_D2 = 14417920;
constexpr size_t W_INA = 69206016, W_INB = 74448896, W_OUT = 76546048, W_MEM = 80740352, W_KVB = 82837504, W_END = 84410368;
static_assert(WS_W + W_END * 2 <= WS_XB && WS_XB + (size_t)MT * 1024 * 2 <= WS_UN && WS_UN + (size_t)MT * 2816 * 2 <= WS_KBP && WS_QO + (size_t)MT * 1024 * 2 <= WS_KP, "ws map");
constexpr size_t KS_L = (size_t)8 * 1056 * 768;
constexpr int LDS_BYTES = 147456;
constexpr float LOG2E = 1.4426950408889634f;

struct Args { const float* in[25]; float* out; unsigned char* ws; };

__device__ __forceinline__ unsigned pk(float lo, float hi) { f32x2_t v = {lo, hi}; bf16x2_t b = __builtin_convertvector(v, bf16x2_t); return __builtin_bit_cast(unsigned, b); }
__device__ __forceinline__ int opaque_tid() { int t = threadIdx.x; asm volatile("" : "+v"(t)); return t; }
__device__ __forceinline__ float wave_sum(float v) {
#pragma unroll
    for (int o = 1; o < 64; o <<= 1) v += __shfl_xor(v, o);
    return v;
}

__device__ __forceinline__ void conv_item(const float* __restrict__ W, int K, int N, bf16_t* WT, int rowoff, const float* __restrict__ g, bool gumap, LAS float* scr, int item, int lane) {
    const int nblk = N / 32, kb = item / nblk, nb = item - kb * nblk, k0 = 64 * kb, n0 = 32 * nb;
    float v[32];
#pragma unroll
    for (int i = 0; i < 32; ++i) v[i] = W[(size_t)(k0 + 2 * i + (lane >> 5)) * N + n0 + (lane & 31)];
    if (g) {
#pragma unroll
        for (int i = 0; i < 32; ++i) v[i] *= g[k0 + 2 * i + (lane >> 5)];
    }
#pragma unroll
    for (int i = 0; i < 32; ++i) scr[(2 * i + (lane >> 5)) * 33 + (lane & 31)] = v[i];
    asm volatile("s_waitcnt lgkmcnt(0)" ::: "memory");
    const int c = lane & 7;
#pragma unroll
    for (int j = 0; j < 4; ++j) {
        const int n = (lane >> 3) + 8 * j; const LAS float* sp = scr + (8 * c) * 33 + n;
        u32x4 o; o.x = pk(sp[0], sp[33]); o.y = pk(sp[66], sp[99]); o.z = pk(sp[132], sp[165]); o.w = pk(sp[198], sp[231]);
        const int nn = n0 + n; int drow = nn;
        if (gumap) { const int half = nn >= 2816 ? 1 : 0, jn = nn - half * 2816; drow = (jn >> 7) * 256 + half * 128 + (jn & 127); }
        *(u32x4*)(WT + (size_t)(rowoff + drow) * K + k0 + 8 * c) = o;
    }
    asm volatile("s_waitcnt lgkmcnt(0)" ::: "memory");
}
__device__ __forceinline__ void conv_w(const float* __restrict__ src, int K, int N, bf16_t* dst, int rowoff, const float* __restrict__ g, bool gumap, LAS float* scr, int gw, int NGW, int lane, int& base) {
    const int nitems = (K / 64) * (N / 32);
    int first = gw - base; if (first < 0) first += NGW;
    for (int it = first; it < nitems; it += NGW) conv_item(src, K, N, dst, rowoff, g, gumap, scr, it, lane);
    base = (base + nitems) % NGW;
}
__device__ __forceinline__ void row1024(const float* src, float* ycopy, bf16_t* xb, float* ssq, int lane) {
    f32x4 v[4]; float s = 0.f;
#pragma unroll
    for (int j = 0; j < 4; ++j) { v[j] = ((const f32x4*)src)[lane + 64 * j]; s += (v[j][0] * v[j][0] + v[j][1] * v[j][1]) + (v[j][2] * v[j][2] + v[j][3] * v[j][3]); }
    s = wave_sum(s);
#pragma unroll
    for (int j = 0; j < 4; ++j) {
        if (ycopy) ((f32x4*)ycopy)[lane + 64 * j] = v[j];
        u32x2 o; o.x = pk(v[j][0], v[j][1]); o.y = pk(v[j][2], v[j][3]); ((u32x2*)xb)[lane + 64 * j] = o;
    }
    if (lane == 0) *ssq = s;
}
__device__ __forceinline__ void cvt_rows(const float* src, bf16_t* dst, int nrows, int rowlen, int srg, int drg, int gw, int NGW, int lane) {
    const int nc = rowlen >> 8;
    for (int row = gw; row < nrows; row += 4 * NGW) {
        f32x4 v[4][3];
#pragma unroll
        for (int q = 0; q < 4; ++q) { const int rw = row + q * NGW;
            if (rw < nrows) {
#pragma unroll
                for (int c = 0; c < 3; ++c) if (c < nc) v[q][c] = *(const f32x4*)(src + (size_t)rw * rowlen + c * 256 + 4 * lane); } }
#pragma unroll
        for (int q = 0; q < 4; ++q) { const int rw = row + q * NGW;
            if (rw < nrows) { const int g = rw / srg, t = rw - g * srg; const size_t drow = (size_t)g * drg + t;
#pragma unroll
                for (int c = 0; c < 3; ++c) if (c < nc) { u32x2 o; o.x = pk(v[q][c][0], v[q][c][1]); o.y = pk(v[q][c][2], v[q][c][3]); *(u32x2*)(dst + drow * rowlen + c * 256 + 4 * lane) = o; } } }
    }
}

__device__ __forceinline__ s16x4 vtr(const LAS unsigned char* p) { return __builtin_bit_cast(s16x4, __builtin_amdgcn_ds_read_tr16_b64_v4i16((LAS v4i16_t*)p)); }
#define MFMA32(a, b, c) __builtin_amdgcn_mfma_f32_32x32x16_bf16((a), (b), (c), 0, 0, 0)

struct AttnState { f32x16 o0, o1; float carry, mrun, lsum; };
template <int MODE>
__device__ __forceinline__ void attn_tile(AttnState& S, const bf16x8 (&qf)[4], const bf16x8 (&kf)[4], const u32x4 (&vr)[4], int k0i, int qpos0, int kpos0,
                                          LAS unsigned char* vwp, const LAS unsigned char* trp, const LAS float* biasT, int r, int h) {
    const float SC = 0.125f * LOG2E;
    f32x16 st;
#pragma unroll
    for (int i = 0; i < 16; ++i) st[i] = 0.f;
#pragma unroll
    for (int s = 0; s < 4; ++s) st = MFMA32(kf[s], qf[s], st);
#pragma unroll
    for (int i = 0; i < 4; ++i) *(LAS u32x4*)(vwp + i * 8 * 144) = vr[i];
    const int dlim = (qpos0 + r) - (kpos0 + k0i) - 4 * h;
    float p[16];
    if constexpr (MODE == 0) {
        float z2[16], lk[16];
#pragma unroll
        for (int i = 0; i < 16; ++i) {
            const int ci = (i & 3) + 8 * (i >> 2);
            z2[i] = st[i] * SC;
            const float t = __builtin_amdgcn_exp2f(-__builtin_fabsf(z2[i]));
            const float sp = __builtin_fmaxf(z2[i], 0.f) + __builtin_amdgcn_logf(1.0f + t);
            lk[i] = (ci < dlim) ? -sp : 0.f;
        }
        float G[4], GP[4];
#pragma unroll
        for (int c = 0; c < 4; ++c) { G[c] = (lk[4 * c] + lk[4 * c + 1]) + (lk[4 * c + 2] + lk[4 * c + 3]); GP[c] = __shfl_xor(G[c], 32); }
        float OS[4], PSE[4], PSI[4];
        OS[3] = 0.f; OS[2] = G[3]; OS[1] = OS[2] + G[2]; OS[0] = OS[1] + G[1];
        PSE[3] = 0.f; PSE[2] = GP[3]; PSE[1] = PSE[2] + GP[2]; PSE[0] = PSE[1] + GP[1];
#pragma unroll
        for (int c = 0; c < 4; ++c) PSI[c] = PSE[c] + GP[c];
#pragma unroll
        for (int c = 0; c < 4; ++c) {
            float aft = S.carry + OS[c] + (h == 0 ? PSI[c] : PSE[c]);
#pragma unroll
            for (int jj = 3; jj >= 0; --jj) {
                const int i = 4 * c + jj; const int ci = (i & 3) + 8 * (i >> 2);
                const float w = __builtin_amdgcn_exp2f(z2[i] + lk[i] + aft);
                p[i] = (ci < dlim) ? w : 0.f;
                aft += lk[i];
            }
        }
        S.carry += (OS[0] + G[0]) + PSI[0];
    } else {
        float s2[16]; float mt = -__builtin_inff();
        const bool farb = (MODE == 1) && ((qpos0 - (kpos0 + k0i) - 31) >= 128);
        const float bfar = (MODE == 1) ? biasT[256] : 0.f;
#pragma unroll
        for (int i = 0; i < 16; ++i) {
            s2[i] = st[i] * SC;
            if constexpr (MODE == 1) {
                if (farb) s2[i] += bfar;
                else { const int ci = (i & 3) + 8 * (i >> 2); int idx = dlim - ci + 128; idx = idx < 0 ? 0 : (idx > 256 ? 256 : idx); s2[i] += biasT[idx]; }
            }
            mt = __builtin_fmaxf(mt, s2[i]);
        }
        mt = __builtin_fmaxf(mt, __shfl_xor(mt, 32));
        const float mnew = __builtin_fmaxf(S.mrun, mt);
        const float alpha = __builtin_amdgcn_exp2f(S.mrun - mnew);
        float ps = 0.f;
#pragma unroll
        for (int i = 0; i < 16; ++i) { p[i] = __builtin_amdgcn_exp2f(s2[i] - mnew); ps += p[i]; }
        S.lsum = S.lsum * alpha + ps; S.mrun = mnew;
#pragma unroll
        for (int i = 0; i < 16; ++i) { S.o0[i] *= alpha; S.o1[i] *= alpha; }
    }
    bf16x8 pb[2], va[2][2];
#pragma unroll
    for (int s2i = 0; s2i < 2; ++s2i) {
        u32x4 pw; pw.x = pk(p[8 * s2i], p[8 * s2i + 1]); pw.y = pk(p[8 * s2i + 2], p[8 * s2i + 3]); pw.z = pk(p[8 * s2i + 4], p[8 * s2i + 5]); pw.w = pk(p[8 * s2i + 6], p[8 * s2i + 7]);
        pb[s2i] = __builtin_bit_cast(bf16x8, pw);
#pragma unroll
        for (int blk = 0; blk < 2; ++blk) {
            const s16x4 lo = vtr(trp + s2i * 2304 + blk * 64), hi = vtr(trp + s2i * 2304 + 1152 + blk * 64);
            va[s2i][blk] = __builtin_shufflevector(lo, hi, 0, 1, 2, 3, 4, 5, 6, 7);
        }
    }
#pragma unroll
    for (int s2i = 0; s2i < 2; ++s2i) { S.o0 = MFMA32(va[s2i][0], pb[s2i], S.o0); S.o1 = MFMA32(va[s2i][1], pb[s2i], S.o1); }
}

template <int MODE>
__device__ __forceinline__ void attn_unit(const bf16_t* Q, const bf16_t* K, const bf16_t* V, bf16_t* O, int kp, int kt_lo, int kt_hi, int qpos0, int kpos0,
                                          LAS unsigned char* vl, const LAS float* biasT, int lane) {
    const int r = lane & 31, h = lane >> 5;
    bf16x8 qf[4];
#pragma unroll
    for (int s = 0; s < 4; ++s) qf[s] = *(const bf16x8*)(Q + (unsigned)(r * 1024 + 16 * s + 8 * h));
    AttnState S;
#pragma unroll
    for (int i = 0; i < 16; ++i) { S.o0[i] = 0.f; S.o1[i] = 0.f; }
    S.carry = 0.f; S.mrun = -__builtin_inff(); S.lsum = 0.f;
    const int nt = kt_hi - kt_lo + 1;
    const int vkey = lane >> 3, vseg = lane & 7;
    const int c16 = (lane >> 4) & 1, q4 = (lane & 15) >> 2, p4 = lane & 3;
    const LAS unsigned char* trp = vl + (4 * h + q4) * 144 + 32 * c16 + 8 * p4;
    LAS unsigned char* vwp = vl + vkey * 144 + vseg * 16;
    const unsigned koff = (unsigned)(r * kp + 8 * h), voff = (unsigned)(vkey * kp + vseg * 8), kp8 = (unsigned)(8 * kp);
    const int step = (MODE == 0) ? -1 : 1;
    int kt = (MODE == 0) ? kt_hi : kt_lo;
    bf16x8 kA[4], kB[4], kC[4]; u32x4 vA[4], vB[4], vC[4];
#define ATT_LOAD(kk, vv, ktile) do { const int _kt = (ktile) < kt_lo ? kt_lo : ((ktile) > kt_hi ? kt_hi : (ktile)); \
        const bf16_t* Kt = K + (size_t)_kt * 32 * kp; const bf16_t* Vt = V + (size_t)_kt * 32 * kp; \
        _Pragma("unroll") for (int s = 0; s < 4; ++s) kk[s] = *(const bf16x8*)(Kt + (koff + 16 * s)); \
        _Pragma("unroll") for (int i = 0; i < 4; ++i) vv[i] = *(const u32x4*)(Vt + (voff + i * kp8)); } while (0)
#define ATT_DONE() (MODE == 0 && __builtin_amdgcn_ballot_w64(S.carry > -150.0f) == 0ull)
    ATT_LOAD(kA, vA, kt);
    ATT_LOAD(kB, vB, kt + step);
    int it = 0; bool done = false;
    for (; it + 2 < nt; it += 3) {
        ATT_LOAD(kC, vC, kt + 2 * step);
        attn_tile<MODE>(S, qf, kA, vA, kt * 32, qpos0, kpos0, vwp, trp, biasT, r, h);
        if (ATT_DONE()) { done = true; break; }
        ATT_LOAD(kA, vA, kt + 3 * step);
        attn_tile<MODE>(S, qf, kB, vB, (kt + step) * 32, qpos0, kpos0, vwp, trp, biasT, r, h);
        if (ATT_DONE()) { done = true; break; }
        ATT_LOAD(kB, vB, kt + 4 * step);
        attn_tile<MODE>(S, qf, kC, vC, (kt + 2 * step) * 32, qpos0, kpos0, vwp, trp, biasT, r, h);
        kt += 3 * step;
        if (ATT_DONE()) { done = true; break; }
    }
    if (!done && it < nt) {
        attn_tile<MODE>(S, qf, kA, vA, kt * 32, qpos0, kpos0, vwp, trp, biasT, r, h);
        if (it + 1 < nt && !ATT_DONE()) attn_tile<MODE>(S, qf, kB, vB, (kt + step) * 32, qpos0, kpos0, vwp, trp, biasT, r, h);
    }
#undef ATT_LOAD
#undef ATT_DONE
    float inv = 1.0f;
    if constexpr (MODE != 0) { const float l = S.lsum + __shfl_xor(S.lsum, 32); inv = 1.0f / l; }
#pragma unroll
    for (int c = 0; c < 4; ++c) {
        u32x2 a, b;
        a.x = pk(S.o0[4 * c] * inv, S.o0[4 * c + 1] * inv); a.y = pk(S.o0[4 * c + 2] * inv, S.o0[4 * c + 3] * inv);
        b.x = pk(S.o1[4 * c] * inv, S.o1[4 * c + 1] * inv); b.y = pk(S.o1[4 * c + 2] * inv, S.o1[4 * c + 3] * inv);
        *(u32x2*)(O + (unsigned)(r * 1024 + 8 * c + 4 * h)) = a;
        *(u32x2*)(O + (unsigned)(r * 1024 + 32 + 8 * c + 4 * h)) = b;
    }
}

struct SmpEpi { int mode; const float* ss; bf16_t* H; bf16_t* XB; float* ssn; float sc; pg8::ProjCtx pc; };
__device__ __forceinline__ void sample_gemm(const bf16_t* A, const bf16_t* Wt, int N, int K, const SmpEpi& E) {
    const int tid = opaque_tid(), lane = tid & 63, wid = __builtin_amdgcn_readfirstlane(tid >> 6);
    const int r = lane & 31, h = lane >> 5;
    const int gwm = wid * gridDim.x + blockIdx.x, NGW = gridDim.x * 8;
    const int ncb = (E.mode == 0) ? 88 : N / 64, nunits = 8 * ncb, nch = K / 32;
    const unsigned loff = (unsigned)(r * K + 16 * h);
    for (int wu = gwm; wu < nunits; wu += NGW) {
        const int rb = wu & 7, cb = wu >> 3;
        int w0, w1;
        if (E.mode == 0) { const int hc0 = 32 * cb; w0 = 256 * (hc0 >> 7) + (hc0 & 127); w1 = w0 + 128; } else { w0 = 64 * cb; w1 = w0 + 32; }
        const bf16_t* pa = A + (size_t)(rb * 32) * K; const bf16_t* pw0 = Wt + (size_t)w0 * K; const bf16_t* pw1 = Wt + (size_t)w1 * K;
        f32x16 c0, c1;
#pragma unroll
        for (int i = 0; i < 16; ++i) { c0[i] = 0.f; c1[i] = 0.f; }
        constexpr int D = 4;
        bf16x8 xa[D][2], wa[D][2], wb[D][2];
#pragma unroll
        for (int d = 0; d < D; ++d) {
            const unsigned o = loff + d * 32;
            xa[d][0] = *(const bf16x8*)(pa + o); xa[d][1] = *(const bf16x8*)(pa + o + 8);
            wa[d][0] = *(const bf16x8*)(pw0 + o); wa[d][1] = *(const bf16x8*)(pw0 + o + 8);
            wb[d][0] = *(const bf16x8*)(pw1 + o); wb[d][1] = *(const bf16x8*)(pw1 + o + 8);
        }
#pragma unroll 1
        for (int ch = 0; ch < nch; ch += D) {
#pragma unroll
            for (int d = 0; d < D; ++d) {
                c0 = MFMA32(wa[d][0], xa[d][0], c0); c1 = MFMA32(wb[d][0], xa[d][0], c1);
                c0 = MFMA32(wa[d][1], xa[d][1], c0); c1 = MFMA32(wb[d][1], xa[d][1], c1);
                const int nx = ch + d + D;
                if (nx < nch) {
                    const unsigned o = loff + nx * 32;
                    xa[d][0] = *(const bf16x8*)(pa + o); xa[d][1] = *(const bf16x8*)(pa + o + 8);
                    wa[d][0] = *(const bf16x8*)(pw0 + o); wa[d][1] = *(const bf16x8*)(pw0 + o + 8);
                    wb[d][0] = *(const bf16x8*)(pw1 + o); wb[d][1] = *(const bf16x8*)(pw1 + o + 8);
                }
            }
        }
        const unsigned rl = rb * 32 + r;
        if (E.mode == 0) {
            const float rs = __builtin_amdgcn_rsqf(E.ss[MP + rl] * (1.0f / 1024.0f) + 1e-6f);
            bf16_t* hp = E.H + (size_t)MP * 2816 + (rl * 2816u + 32 * cb + 4 * h);
#pragma unroll
            for (int c = 0; c < 4; ++c) {
                float hv[4];
#pragma unroll
                for (int j = 0; j < 4; ++j) { const float g = c0[4 * c + j] * rs, up = c1[4 * c + j] * rs; hv[j] = g * up * __builtin_amdgcn_rcpf(1.0f + __expf(-g)); }
                u32x2 o; o.x = pk(hv[0], hv[1]); o.y = pk(hv[2], hv[3]); *(u32x2*)(hp + 8 * c) = o;
            }
        } else if (E.mode == 1) {
            float part = 0.f;
            bf16_t* bp = E.XB + (size_t)MP * 1024 + (rl * 1024u + 64 * cb + 4 * h);
            u32x2 win[2][4];
#pragma unroll
            for (int blk = 0; blk < 2; ++blk)
#pragma unroll
                for (int c = 0; c < 4; ++c) win[blk][c] = *(const u32x2*)(bp + 32 * blk + 8 * c);
#pragma unroll
            for (int blk = 0; blk < 2; ++blk)
#pragma unroll
                for (int c = 0; c < 4; ++c) {
                    const u32x2 w = win[blk][c];
                    f32x4 x; x[0] = __builtin_bit_cast(float, w.x << 16); x[1] = __builtin_bit_cast(float, w.x & 0xffff0000u); x[2] = __builtin_bit_cast(float, w.y << 16); x[3] = __builtin_bit_cast(float, w.y & 0xffff0000u);
#pragma unroll
                    for (int j = 0; j < 4; ++j) { x[j] += E.sc * (blk ? c1[4 * c + j] : c0[4 * c + j]); part += x[j] * x[j]; }
                    u32x2 o; o.x = pk(x[0], x[1]); o.y = pk(x[2], x[3]); *(u32x2*)(bp + 32 * blk + 8 * c) = o;
                }
            part += __shfl_xor(part, 32);
            if (h == 0) unsafeAtomicAdd(E.ssn + MP + rl, part);
        } else {
            const float rs = __builtin_amdgcn_rsqf(E.ss[MP + rl] * (1.0f / 1024.0f) + 1e-6f);
#pragma unroll
            for (int blk = 0; blk < 2; ++blk) {
                const int n0 = 64 * cb + 32 * blk;
                pg8::Unit u; u.pm = 256; u.pn = n0 >> 8;
                const pg8::Route rt = pg8::route_unit(E.pc, u);
                const unsigned rbw = rt.grp ? (rl >> 5) * (unsigned)rt.grp + (rl & 31u) : rl, cl = (unsigned)(n0 & 255) + 4 * h;
#pragma unroll
                for (int c = 0; c < 4; ++c) {
                    f32x4 v;
#pragma unroll
                    for (int j = 0; j < 4; ++j) v[j] = (blk ? c1[4 * c + j] : c0[4 * c + j]) * rs;
                    if (rt.b) { u32x2 o; o.x = pk(v[0], v[1]); o.y = pk(v[2], v[3]); *(u32x2*)(rt.b + (rbw * (unsigned)rt.ldb + cl + 8 * c)) = o; }
                    if (rt.f) *(f32x4*)(rt.f + (rl * (unsigned)rt.ldf + cl + 8 * c)) = v;
                }
            }
        }
    }
}

#define XB_TMO      128
#define XB_XCNT(j)  (256  + 64 * (j))
#define XB_XSUB(j)  (1280 + 64 * (j))
#define XB_XGEN(j)  (2304 + 64 * (j))
#define XB_TOP      3328
#define XB_TOPGEN   3392
#define XCD_BAR_WORDS 3456
#define XB_SPIN_CAP (1u << 18)

__device__ __forceinline__ unsigned xb_ld(unsigned* p)              { return __hip_atomic_load(p, __ATOMIC_RELAXED, __HIP_MEMORY_SCOPE_AGENT); }
__device__ __forceinline__ unsigned xb_add(unsigned* p, unsigned v) { return __hip_atomic_fetch_add(p, v, __ATOMIC_RELAXED, __HIP_MEMORY_SCOPE_AGENT); }
__device__ __forceinline__ unsigned xb_xcc_id() { return (unsigned)__builtin_amdgcn_s_getreg((3 << 11) | 20) & 0xFu; }
#define XB_SPIN(cond, bar) do { unsigned _sp = 0; while (cond) { __builtin_amdgcn_s_sleep(1); \
    if ((++_sp & 255u) == 0u) { if (xb_ld(&(bar)[XB_TMO])) break; if (_sp > XB_SPIN_CAP) { atomicAdd(&(bar)[XB_TMO], 1u); break; } } } } while (0)

struct XcdBarrier {
    unsigned* bar; unsigned x;
    volatile LAS unsigned* st;
};

__device__ __forceinline__ XcdBarrier xcd_barrier_post(unsigned* bar, volatile LAS unsigned* st) {
    XcdBarrier b; b.bar = bar; b.x = xb_xcc_id(); b.st = st;
    if (threadIdx.x == 0) (void)xb_add(&bar[XB_XCNT(b.x)], 1u);
    return b;
}
__device__ __forceinline__ void xcd_barrier_complete(unsigned* bar, unsigned x, unsigned& nloc, unsigned& nx) {
    const unsigned G = gridDim.x * gridDim.y * gridDim.z;
    unsigned sum, cnt, mine, sp = 0u;
    for (;;) {
        sum = 0u; cnt = 0u; mine = 0u;
#pragma unroll
        for (unsigned j = 0; j < 16; ++j) { const unsigned c = xb_ld(&bar[XB_XCNT(j)]); sum += c; cnt += (c > 0u) ? 1u : 0u; mine = (j == x) ? c : mine; }
        if (sum == G) break;
        __builtin_amdgcn_s_sleep(1);
        if ((++sp & 255u) == 0u) { if (xb_ld(&bar[XB_TMO])) break; if (sp > XB_SPIN_CAP) { atomicAdd(&bar[XB_TMO], 1u); break; } }
    }
    nloc = mine > 0u ? mine : 1u; nx = cnt > 0u ? cnt : 1u;
}

__device__ __forceinline__ void xcd_barrier(const XcdBarrier& b) {
    asm volatile("s_waitcnt vmcnt(0)" ::: "memory");
    __syncthreads();
    if (threadIdx.x == 0) {
        unsigned* bar = b.bar;
        __builtin_amdgcn_s_waitcnt(0);
        unsigned nloc = b.st[0], nx = b.st[1];
        if (nloc == 0u) { xcd_barrier_complete(bar, b.x, nloc, nx); b.st[0] = nloc; b.st[1] = nx; }
        const unsigned old = xb_add(&bar[XB_XSUB(b.x)], 1u);
        const unsigned gen = old / nloc;
        if (old + 1u == (gen + 1u) * nloc) {
            __builtin_amdgcn_fence(__ATOMIC_RELEASE, "agent");
            asm volatile("s_waitcnt vmcnt(0)" ::: "memory");
            const unsigned og = xb_add(&bar[XB_TOP], 1u);
            const unsigned tg = og / nx;
            if (og + 1u == (tg + 1u) * nx) xb_add(&bar[XB_TOPGEN], 1u);
            else XB_SPIN(xb_ld(&bar[XB_TOPGEN]) == tg, bar);
            __builtin_amdgcn_fence(__ATOMIC_ACQUIRE, "agent");
            xb_add(&bar[XB_XGEN(b.x)], 1u);
            asm volatile("s_waitcnt vmcnt(0)" ::: "memory");
        } else {
            XB_SPIN(xb_ld(&bar[XB_XGEN(b.x)]) == gen, bar);
            __builtin_amdgcn_fence(__ATOMIC_ACQUIRE, "agent");
            asm volatile("s_waitcnt vmcnt(0)" ::: "memory");
        }
    }
    __syncthreads();
}


struct Ptrs {
    float* out; float* ss;
    bf16_t *W, *XB, *HID, *QO, *Kp, *Vp, *KBp, *VBp, *MEMB, *Ks, *Vs, *KBs, *VBs, *MKV, *MKS, *MVS;
};

__device__ __forceinline__ void attn_phase(const Ptrs& P, int l, const float* relb, LAS unsigned char* lds) {
    const int tid = opaque_tid(), lane = tid & 63, wid = __builtin_amdgcn_readfirstlane(tid >> 6);
    LAS unsigned char* vl = lds + wid * 4608;
    LAS float* biasL = (LAS float*)(lds + 40960);
    if (l >= 2) {
        for (int i = tid; i < 12 * 257; i += 512) biasL[i] = relb[(size_t)(l - 2) * 12 * 257 + i] * LOG2E;
        __syncthreads();
    }
    constexpr int NW1 = 3072, NW3 = 1024, NS = 128;
    const int gwm = wid * gridDim.x + blockIdx.x;
    const int nrounds = (NW1 + NW3 + (int)gridDim.x - 1) / (int)gridDim.x;
    for (int it = -1; it < nrounds; ++it) {
        const bf16_t *K, *V; bf16_t* Q; int kp = 768, kt_lo = 0, kt_hi = 0, qpos0 = 0, kpos0 = 0, mode, hd = 0;
        if (it < 0) {
            if (gwm >= NS) continue;
            if (gwm < 96) {
                const int b = gwm / 12; hd = gwm - b * 12;
                Q = P.QO + ((size_t)MP + 32 * b) * 1024 + hd * 64; qpos0 = 1024;
                if (l < 2) { mode = 0; K = P.Ks + (size_t)l * KS_L + (size_t)b * 1056 * 768 + hd * 64; V = P.Vs + (size_t)l * KS_L + (size_t)b * 1056 * 768 + hd * 64; kt_hi = 32; }
                else { mode = 1; K = P.KBs + (size_t)b * 544 * 768 + hd * 64; V = P.VBs + (size_t)b * 544 * 768 + hd * 64; kt_hi = 16; kpos0 = 512; }
            } else {
                const int v = gwm - 96, b = v >> 2, mh = v & 3;
                mode = 2; Q = P.QO + ((size_t)MP + 32 * b) * 1024 + 768 + mh * 64;
                K = P.MKS + ((size_t)(l * 8 + b) * 256) * 256 + mh * 64; V = P.MVS + ((size_t)(l * 8 + b) * 256) * 256 + mh * 64; kp = 256; kt_hi = 7;
            }
        } else {
            const int wu = it * (int)gridDim.x + (int)blockIdx.x;
            if (wu >= NW1 + NW3) continue;
            if (wu < NW1) {
                const int qb8 = wu / 384, bh = wu - qb8 * 384, qb = 8 * qb8 + wid, b = bh / 12; hd = bh - b * 12;
                Q = P.QO + ((size_t)b * 2048 + 32 * qb) * 1024 + hd * 64; qpos0 = 32 * qb;
                if (l < 2) { mode = 0; K = P.Kp + (size_t)b * 2048 * 768 + hd * 64; V = P.Vp + (size_t)b * 2048 * 768 + hd * 64; kt_hi = qb; }
                else { mode = 1; const int c = qb >> 1; K = P.KBp + (size_t)b * 2048 * 768 + hd * 64; V = P.VBp + (size_t)b * 2048 * 768 + hd * 64; kt_lo = c > 8 ? 2 * (c - 8) : 0; kt_hi = 2 * c + 1; }
            } else {
                const int v = wu - NW1, qb8 = v >> 7, bh = v & 127, b = bh >> 2, mh = bh & 3, qb = 8 * qb8 + wid;
                mode = 2; Q = P.QO + ((size_t)b * 2048 + 32 * qb) * 1024 + 768 + mh * 64;
                K = P.MKV + (size_t)b * 256 * 2048 + l * 512 + mh * 64; V = K + 256; kp = 2048; kt_hi = 7;
            }
        }
        if (mode == 0) attn_unit<0>(Q, K, V, Q, kp, kt_lo, kt_hi, qpos0, kpos0, vl, biasL, lane);
        else if (mode == 1) attn_unit<1>(Q, K, V, Q, kp, kt_lo, kt_hi, qpos0, kpos0, vl, biasL + hd * 257, lane);
        else attn_unit<2>(Q, K, V, Q, kp, kt_lo, kt_hi, qpos0, kpos0, vl, biasL, lane);
    }
    __syncthreads();
}

__global__ void __launch_bounds__(512) yoco_fwd(Args a) {
    extern __shared__ __attribute__((aligned(16))) unsigned char smem[];
    LAS unsigned char* lds = (LAS unsigned char*)smem;
    cg::grid_group grid = cg::this_grid();
    const int G = gridDim.x, NGW = G * 8;
    unsigned char* ws = a.ws;
    Ptrs P;
    P.out = a.out; P.ss = (float*)(ws + WS_SS);
    P.W = (bf16_t*)(ws + WS_W); P.XB = (bf16_t*)(ws + WS_XB); P.HID = (bf16_t*)(ws + WS_UN); P.QO = (bf16_t*)(ws + WS_QO); P.Kp = (bf16_t*)(ws + WS_KP); P.Vp = (bf16_t*)(ws + WS_VP);
    P.KBp = (bf16_t*)(ws + WS_KBP); P.VBp = (bf16_t*)(ws + WS_VBP); P.MEMB = (bf16_t*)(ws + WS_MEMB); P.Ks = (bf16_t*)(ws + WS_KS); P.Vs = (bf16_t*)(ws + WS_VS);
    P.KBs = (bf16_t*)(ws + WS_KBS); P.VBs = (bf16_t*)(ws + WS_VBS); P.MKV = (bf16_t*)(ws + WS_MKV); P.MKS = (bf16_t*)(ws + WS_MKS); P.MVS = (bf16_t*)(ws + WS_MVS);
    volatile LAS unsigned* bst = (volatile LAS unsigned*)(lds + LDS_BYTES - 64);
    if (threadIdx.x == 0) { bst[0] = 0u; bst[1] = 0u; }
    __syncthreads();
    const XcdBarrier xbar = xcd_barrier_post((unsigned*)(ws + WS_BAR), bst);
    float* Y = a.out;

    {
        const int tid = opaque_tid(), lane = tid & 63, wid = __builtin_amdgcn_readfirstlane(tid >> 6), gw = blockIdx.x * 8 + wid;
        LAS float* scr = (LAS float*)(lds + wid * 8448); int cbase = 0;
        for (int l = 0; l < 4; ++l) {
            bf16_t* wl = P.W + (size_t)l * W_L;
            conv_w(a.in[10] + (size_t)l * 1024 * 5632, 1024, 5632, wl + W_GU1, 0, a.in[9] + l * 1024, true, scr, gw, NGW, lane, cbase);
            conv_w(a.in[11] + (size_t)l * 2816 * 1024, 2816, 1024, wl + W_D1, 0, nullptr, false, scr, gw, NGW, lane, cbase);
            conv_w(a.in[22] + (size_t)l * 1024 * 5632, 1024, 5632, wl + W_GU2, 0, a.in[21] + l * 1024, true, scr, gw, NGW, lane, cbase);
            conv_w(a.in[23] + (size_t)l * 2816 * 1024, 2816, 1024, wl + W_D2, 0, nullptr, false, scr, gw, NGW, lane, cbase);
            conv_w(a.in[15] + (size_t)l * 1024 * 1024, 1024, 1024, P.W + W_OUT + (size_t)l * 1048576, 0, nullptr, false, scr, gw, NGW, lane, cbase);
            conv_w(a.in[17] + (size_t)l * 1024 * 512, 1024, 512, P.W + W_MEM, l * 512, a.in[16] + l * 1024, false, scr, gw, NGW, lane, cbase);
            if (l < 2) conv_w(a.in[13] + (size_t)l * 1024 * 2560, 1024, 2560, P.W + W_INA + (size_t)l * 2621440, 0, a.in[12] + l * 1024, false, scr, gw, NGW, lane, cbase);
            else       conv_w(a.in[14] + (size_t)(l - 2) * 1024 * 1024, 1024, 1024, P.W + W_INB + (size_t)(l - 2) * 1048576, 0, a.in[12] + l * 1024, false, scr, gw, NGW, lane, cbase);
        }
        conv_w(a.in[19], 1024, 1536, P.W + W_KVB, 0, a.in[18], false, scr, gw, NGW, lane, cbase);
        for (int row = gw; row < MT; row += 4 * NGW) {
            f32x4 v[4][4]; float sq[4];
#pragma unroll
            for (int q = 0; q < 4; ++q) { const int rw = row + q * NGW; sq[q] = 0.f;
                if (rw < MT) { const float* src = rw < MP ? a.in[0] + (size_t)rw * 1024 : a.in[1] + (size_t)(rw - MP) * 1024;
#pragma unroll
                    for (int j = 0; j < 4; ++j) v[q][j] = ((const f32x4*)src)[lane + 64 * j]; } }
#pragma unroll
            for (int q = 0; q < 4; ++q) { const int rw = row + q * NGW;
                if (rw < MT) {
#pragma unroll
                    for (int j = 0; j < 4; ++j) sq[q] += (v[q][j][0] * v[q][j][0] + v[q][j][1] * v[q][j][1]) + (v[q][j][2] * v[q][j][2] + v[q][j][3] * v[q][j][3]);
                    sq[q] = wave_sum(sq[q]);
#pragma unroll
                    for (int j = 0; j < 4; ++j) { u32x2 o; o.x = pk(v[q][j][0], v[q][j][1]); o.y = pk(v[q][j][2], v[q][j][3]); ((u32x2*)(P.XB + (size_t)rw * 1024))[lane + 64 * j] = o; }
                    if (lane == 0) P.ss[rw] = sq[q];
                } }
        }
        for (int row = gw; row < 8192; row += NGW) row1024(a.in[8] + (size_t)row * 1024, nullptr, P.MEMB + (size_t)row * 1024, P.ss + SS_MEM + row, lane);
        cvt_rows(a.in[2], P.Ks, 16384, 768, 1024, 1056, gw, NGW, lane);
        cvt_rows(a.in[3], P.Vs, 16384, 768, 1024, 1056, gw, NGW, lane);
        cvt_rows(a.in[4], P.KBs, 4096, 768, 512, 544, gw, NGW, lane);
        cvt_rows(a.in[5], P.VBs, 4096, 768, 512, 544, gw, NGW, lane);
        cvt_rows(a.in[6], P.MKS, 8192, 256, 1, 1, gw, NGW, lane);
        cvt_rows(a.in[7], P.MVS, 8192, 256, 1, 1, gw, NGW, lane);
        for (size_t i = (size_t)blockIdx.x * 512 + tid; i < 12 * SS_STRIDE; i += (size_t)G * 512) P.ss[SS_STRIDE + i] = 0.f;
    }
    grid.sync();

    pg8::StaticOrder so;
    pg8::ProjCtx pc; pc.kind = 0; pc.l = 0; pc.QO = P.QO; pc.Kp = P.Kp; pc.Vp = P.Vp; pc.Ks = P.Ks; pc.Vs = P.Vs; pc.KBp = P.KBp; pc.VBp = P.VBp; pc.KBs = P.KBs; pc.VBs = P.VBs; pc.MKV = P.MKV; pc.out = a.out;
    {
        pg8::Gemm g{P.MEMB, P.W + W_MEM, 8192, 2048, 1024}; so.init(8192, 2048, G, blockIdx.x);
        pg8::EpiProj e; e.ss = P.ss + SS_MEM; e.c = pc; e.c.kind = 3;
        pg8::gemm_phase<pg8::EpiProj, pg8::StaticOrder, true, true>(lds, g, so, e);
    }
#pragma unroll 1
    for (int l = 0; l < 4; ++l) {
        bf16_t* wl = P.W + (size_t)l * W_L;
        float* ss0 = P.ss + (size_t)(3 * l) * SS_STRIDE;
        { SmpEpi se{}; se.mode = 0; se.ss = ss0; se.H = P.HID; sample_gemm(P.XB + (size_t)MP * 1024, wl + W_GU1, 5632, 1024, se); }
        { pg8::Gemm g{P.XB, wl + W_GU1, MP, 5632, 1024}; so.init(MP, 5632, G, blockIdx.x); pg8::EpiGU e{P.HID, ss0};
          pg8::gemm_phase<pg8::EpiGU, pg8::StaticOrder, true, true>(lds, g, so, e); }
        xcd_barrier(xbar);
        { SmpEpi se{}; se.mode = 1; se.XB = P.XB; se.ssn = ss0 + SS_STRIDE; se.sc = 0.5f; sample_gemm(P.HID + (size_t)MP * 2816, wl + W_D1, 1024, 2816, se); }
        { pg8::Gemm g{P.HID, wl + W_D1, MP, 1024, 2816}; so.init(MP, 1024, G, blockIdx.x); pg8::EpiRes e{P.XB, ss0 + SS_STRIDE, 0.5f};
          pg8::gemm_phase<pg8::EpiRes, pg8::StaticOrder, true, true>(lds, g, so, e); }
        xcd_barrier(xbar);
        {
            pg8::EpiProj e; e.ss = ss0 + SS_STRIDE; e.c = pc; e.c.l = l;
            if (l < 2) { e.c.kind = 0; e.c.Ks = P.Ks + (size_t)l * KS_L; e.c.Vs = P.Vs + (size_t)l * KS_L;
                { SmpEpi se{}; se.mode = 2; se.ss = e.ss; se.pc = e.c; sample_gemm(P.XB + (size_t)MP * 1024, P.W + W_INA + (size_t)l * 2621440, 2560, 1024, se); }
                pg8::Gemm g{P.XB, P.W + W_INA + (size_t)l * 2621440, MP, 2560, 1024}; so.init(MP, 2560, G, blockIdx.x);
                pg8::gemm_phase<pg8::EpiProj, pg8::StaticOrder, true, true>(lds, g, so, e); }
            else { e.c.kind = 1;
                { SmpEpi se{}; se.mode = 2; se.ss = e.ss; se.pc = e.c; sample_gemm(P.XB + (size_t)MP * 1024, P.W + W_INB + (size_t)(l - 2) * 1048576, 1024, 1024, se); }
                pg8::Gemm g{P.XB, P.W + W_INB + (size_t)(l - 2) * 1048576, MP, 1024, 1024}; so.init(MP, 1024, G, blockIdx.x);
                pg8::gemm_phase<pg8::EpiProj, pg8::StaticOrder, true, true>(lds, g, so, e); }
        }
        xcd_barrier(xbar);
        attn_phase(P, l, a.in[20], lds);
        xcd_barrier(xbar);
        { SmpEpi se{}; se.mode = 1; se.XB = P.XB; se.ssn = ss0 + 2 * SS_STRIDE; se.sc = 1.0f; sample_gemm(P.QO + (size_t)MP * 1024, P.W + W_OUT + (size_t)l * 1048576, 1024, 1024, se); }
        { pg8::Gemm g{P.QO, P.W + W_OUT + (size_t)l * 1048576, MP, 1024, 1024}; so.init(MP, 1024, G, blockIdx.x); pg8::EpiRes e{P.XB, ss0 + 2 * SS_STRIDE, 1.0f};
          pg8::gemm_phase<pg8::EpiRes, pg8::StaticOrder, true, true>(lds, g, so, e); }
        xcd_barrier(xbar);
        { SmpEpi se{}; se.mode = 0; se.ss = ss0 + 2 * SS_STRIDE; se.H = P.HID; sample_gemm(P.XB + (size_t)MP * 1024, wl + W_GU2, 5632, 1024, se); }
        { pg8::Gemm g{P.XB, wl + W_GU2, MP, 5632, 1024}; so.init(MP, 5632, G, blockIdx.x); pg8::EpiGU e{P.HID, ss0 + 2 * SS_STRIDE};
          pg8::gemm_phase<pg8::EpiGU, pg8::StaticOrder, true, true>(lds, g, so, e); }
        xcd_barrier(xbar);
        { SmpEpi se{}; se.mode = 1; se.XB = P.XB; se.ssn = ss0 + 3 * SS_STRIDE; se.sc = 0.5f; sample_gemm(P.HID + (size_t)MP * 2816, wl + W_D2, 1024, 2816, se); }
        { pg8::Gemm g{P.HID, wl + W_D2, MP, 1024, 2816}; so.init(MP, 1024, G, blockIdx.x); pg8::EpiRes e{P.XB, ss0 + 3 * SS_STRIDE, 0.5f};
          pg8::gemm_phase<pg8::EpiRes, pg8::StaticOrder, true, true>(lds, g, so, e); }
        xcd_barrier(xbar);
        if (l == 1) {
            pg8::EpiProj e; e.ss = ss0 + 3 * SS_STRIDE; e.c = pc; e.c.kind = 2;
            { SmpEpi se{}; se.mode = 2; se.ss = e.ss; se.pc = e.c; sample_gemm(P.XB + (size_t)MP * 1024, P.W + W_KVB, 1536, 1024, se); }
            pg8::Gemm g{P.XB, P.W + W_KVB, MP, 1536, 1024}; so.init(MP, 1536, G, blockIdx.x);
            pg8::gemm_phase<pg8::EpiProj, pg8::StaticOrder, true, true>(lds, g, so, e);
        }
    }
    {
        const int tid = opaque_tid(), lane = tid & 63, wid = __builtin_amdgcn_readfirstlane(tid >> 6), gw = blockIdx.x * 8 + wid;
        const float* ssf = P.ss + 12 * SS_STRIDE; const float* gf = a.in[24];
        f32x4 gg[4];
#pragma unroll
        for (int j = 0; j < 4; ++j) gg[j] = ((const f32x4*)gf)[lane + 64 * j];
        for (int row = gw; row < MT; row += 4 * NGW) {
            u32x2 w[4][4]; float rs[4];
#pragma unroll
            for (int q = 0; q < 4; ++q) { const int rw = row + q * NGW;
                if (rw < MT) { rs[q] = ssf[rw]; const u32x2* xp = (const u32x2*)(P.XB + (size_t)rw * 1024);
#pragma unroll
                    for (int j = 0; j < 4; ++j) w[q][j] = xp[lane + 64 * j]; } }
#pragma unroll
            for (int q = 0; q < 4; ++q) { const int rw = row + q * NGW;
                if (rw < MT) { const float r1 = __builtin_amdgcn_rsqf(rs[q] * (1.0f / 1024.0f) + 1e-6f); f32x4* yp = (f32x4*)(Y + (size_t)rw * 1024);
#pragma unroll
                    for (int j = 0; j < 4; ++j) { f32x4 v;
                        v[0] = __builtin_bit_cast(float, w[q][j].x << 16); v[1] = __builtin_bit_cast(float, w[q][j].x & 0xffff0000u); v[2] = __builtin_bit_cast(float, w[q][j].y << 16); v[3] = __builtin_bit_cast(float, w[q][j].y & 0xffff0000u);
                        yp[lane + 64 * j] = v * r1 * gg[j]; } } }
        }
    }
}
}

extern "C" void kernel_launch(void* const* d_in, const int* in_sizes, int n_in, void* d_out, int out_size, void* d_ws, size_t ws_size, hipStream_t stream) {
    static int grid = 0;
    if (grid == 0) {
        if (n_in != 25 || (size_t)out_size != pg8::O_END || ws_size < mk::WS_END) { fprintf(stderr, "kernel_launch: unexpected shapes: n_in %d out %d ws %zu\n", n_in, out_size, ws_size); grid = -1; return; }
        int dev = 0, cus = 0, per_cu = 0;
        hipGetDevice(&dev); hipDeviceGetAttribute(&cus, hipDeviceAttributeMultiprocessorCount, dev);
        if (hipFuncSetAttribute((const void*)mk::yoco_fwd, hipFuncAttributeMaxDynamicSharedMemorySize, mk::LDS_BYTES) != hipSuccess) { fprintf(stderr, "kernel_launch: hipFuncSetAttribute failed\n"); grid = -1; return; }
        if (hipOccupancyMaxActiveBlocksPerMultiprocessor(&per_cu, (const void*)mk::yoco_fwd, 512, mk::LDS_BYTES) != hipSuccess || per_cu < 1) { fprintf(stderr, "kernel_launch: occupancy query says %d\n", per_cu); per_cu = 1; }
        (void)hipGetLastError();
        grid = cus;
    }
    if (grid < 0) return;
    if (hipMemsetAsync((char*)d_ws + mk::WS_BAR, 0, mk::BAR_BYTES, stream) != hipSuccess) { fprintf(stderr, "kernel_launch: hipMemsetAsync failed\n"); return; }
    mk::Args a{};
    for (int i = 0; i < 25; ++i) a.in[i] = (const float*)d_in[i];
    a.out = (float*)d_out; a.ws = (unsigned char*)d_ws;
    void* args[] = {&a};
    hipError_t e = hipLaunchCooperativeKernel((const void*)mk::yoco_fwd, dim3(grid), dim3(512), args, mk::LDS_BYTES, stream);
    if (e != hipSuccess) fprintf(stderr, "cooperative launch failed: %s (grid %d)\n", hipGetErrorString(e), grid);
}
```
